# Optimizing an MI355X kernel written in HIP

```python
import jax, jax.numpy as jnp
from jax import lax
import numpy as np


D_MODEL = 1024
BATCH = 32
SEQ = 2048
DEPTH = 4

GRID_W = 64
CTX_LEN = 256
N_MIXERS = 2
N_FOURIER_GROUPS = 4
FOURIER_GROUP = D_MODEL // N_FOURIER_GROUPS
D_RNN = (4 * D_MODEL // 3) // 64 * 64
N_RNN_BLOCKS = 16
RNN_BLOCK = D_RNN // N_RNN_BLOCKS
CONV_W = 4
CONV_LEFT = CONV_W // 2
RG_C = 8.0
D_FF = 4 * D_MODEL
N_FOURIER_LAYERS = (DEPTH + 1) // 2
N_RNN_LAYERS = DEPTH // 2
EPS = 1e-6

kernel_name = 'hybrid_fnet_rglru_prefix_dit'


def rmsnorm(x, g):
    xf = x.astype(jnp.float32)
    y = xf * lax.rsqrt(jnp.mean(xf * xf, axis=-1, keepdims=True) + EPS)
    return (y * g.astype(jnp.float32)).astype(x.dtype)


def modulate(h, shift, scale):
    return h * (1 + scale) + shift


def fourier_mix(h, w_out):
    B, T, D = h.shape
    hg = h.astype(jnp.float32).reshape(B, T, N_FOURIER_GROUPS, FOURIER_GROUP)
    f = jnp.fft.fftn(hg, axes=(1, 3), norm='ortho').real
    return f.reshape(B, T, D).astype(h.dtype) @ w_out


def centred_dwconv(u, w, b):
    T = u.shape[1]
    up = jnp.pad(u, ((0, 0), (CONV_LEFT, CONV_W - 1 - CONV_LEFT), (0, 0)))
    out = b
    for k in range(CONV_W):
        out = out + w[k] * up[:, k:k + T]
    return out


def _combine(l, r):
    a_l, b_l = l
    a_r, b_r = r
    return a_l * a_r, a_r * b_l + b_r


def linear_recurrence(a, b, h0, reverse):
    if reverse:
        a, b = jnp.flip(a, 1), jnp.flip(b, 1)
    if h0 is not None:
        b = b.at[:, 0].add(a[:, 0] * h0)
    _, h = lax.associative_scan(_combine, (a, b), axis=1)
    if reverse:
        h = jnp.flip(h, 1)
    return h


def rglru_direction(xr, w_a, b_a, w_i, b_i, lam, h0, reverse):
    B, T, _ = xr.shape
    xb = xr.reshape(B, T, N_RNN_BLOCKS, RNN_BLOCK)
    r = jax.nn.sigmoid(jnp.einsum('btni,nij->btnj', xb, w_a).reshape(B, T, D_RNN) + b_a)
    ig = jax.nn.sigmoid(jnp.einsum('btni,nij->btnj', xb, w_i).reshape(B, T, D_RNN) + b_i)
    log_a = (-RG_C * r.astype(jnp.float32)) * jax.nn.softplus(-lam.astype(jnp.float32))
    a = jnp.exp(log_a)
    mult = jnp.sqrt(-jnp.expm1(2.0 * log_a))
    bterm = mult * (ig * xr).astype(jnp.float32)
    return linear_recurrence(a, bterm, h0, reverse)


def rglru_branch(h, w_in, conv_w, conv_b, w_a, b_a, w_i, b_i, lam, h0_f, h0_b):
    u = h @ w_in
    gate, xr = jnp.split(u, 2, axis=-1)
    xr = centred_dwconv(xr, conv_w, conv_b)
    hf = rglru_direction(xr, w_a[0], b_a[0], w_i[0], b_i[0], lam[0], h0_f, False)
    hb = rglru_direction(xr, w_a[1], b_a[1], w_i[1], b_i[1], lam[1], h0_b, True)
    return hf, hb, gate


def rglru_readout(hf, hb, gate, w_out):
    return ((hf + hb).astype(gate.dtype) * jax.nn.gelu(gate)) @ w_out


def sq_relu_mlp(h, w1, b1, w2, b2):
    return jnp.square(jax.nn.relu(h @ w1 + b1)) @ w2 + b2


def setup_inputs(seed: int = 0) -> dict:
    key = jax.random.key(seed)
    ks = jax.random.split(key, 24)
    D = D_MODEL
    nr, nf = N_RNN_LAYERS, N_FOURIER_LAYERS
    f32 = jnp.float32
    nrm = lambda k, shape, s: jax.random.normal(k, shape, f32) * s
    a0 = jax.random.uniform(ks[15], (nr, 2, D_RNN), f32, minval=0.9, maxval=0.999)
    s = a0 ** (1.0 / RG_C)
    lam = jnp.log(s) - jnp.log1p(-s)
    return {
        'x': nrm(ks[0], (BATCH, SEQ, D), 1.0),
        'c': nrm(ks[1], (BATCH, D), 1.0),
        'ctx': nrm(ks[2], (BATCH, CTX_LEN, D), 1.0),
        'c_ctx': nrm(ks[3], (D,), 1.0),
        'w_mod': nrm(ks[4], (DEPTH, D, 6 * D), 0.5 * D ** -0.5),
        'b_mod': nrm(ks[5], (DEPTH, 6 * D), 0.02),
        'norm_g': 1.0 + nrm(ks[6], (DEPTH, 2, D), 0.02),
        'w_fourier': nrm(ks[7], (nf, D, D), D ** -0.5),
        'w_rnn_in': nrm(ks[8], (nr, D, 2 * D_RNN), D ** -0.5),
        'conv_w': nrm(ks[9], (nr, CONV_W, D_RNN), CONV_W ** -0.5),
        'conv_b': nrm(ks[10], (nr, D_RNN), 0.02),
        'w_a': nrm(ks[11], (nr, 2, N_RNN_BLOCKS, RNN_BLOCK, RNN_BLOCK), RNN_BLOCK ** -0.5),
        'b_a': nrm(ks[12], (nr, 2, D_RNN), 0.02),
        'w_i': nrm(ks[13], (nr, 2, N_RNN_BLOCKS, RNN_BLOCK, RNN_BLOCK), RNN_BLOCK ** -0.5),
        'b_i': nrm(ks[14], (nr, 2, D_RNN), 0.02),
        'lam': lam,
        'w_rnn_out': nrm(ks[16], (nr, D_RNN, D), D_RNN ** -0.5),
        'w1': nrm(ks[17], (DEPTH, D, D_FF), D ** -0.5),
        'b1': nrm(ks[18], (DEPTH, D_FF), 0.02),
        'w2': nrm(ks[19], (DEPTH, D_FF, D), D_FF ** -0.5),
        'b2': nrm(ks[20], (DEPTH, D), 0.02),
        'final_g': 1.0 + nrm(ks[21], (D,), 0.02),
    }


def reference(x, c, ctx, c_ctx, w_mod, b_mod, norm_g, w_fourier, w_rnn_in, conv_w, conv_b,
              w_a, b_a, w_i, b_i, lam, w_rnn_out, w1, b1, w2, b2, final_g):
    s_c = jax.nn.silu(c)
    s_cc = jax.nn.silu(c_ctx)
    for i in range(DEPTH):
        last = i == DEPTH - 1
        j = i // N_MIXERS
        mod_x = (s_c @ w_mod[i] + b_mod[i])[:, None, :]
        mod_c = (s_cc @ w_mod[i] + b_mod[i])[None, None, :]
        shx, scx, gx, shx2, scx2, gx2 = jnp.split(mod_x, 6, axis=-1)
        shc, scc, gc, shc2, scc2, gc2 = jnp.split(mod_c, 6, axis=-1)
        hx = modulate(rmsnorm(x, norm_g[i, 0]), shx, scx)
        if i % N_MIXERS == 0:
            yx = fourier_mix(hx, w_fourier[j])
            if not last:
                hc = modulate(rmsnorm(ctx, norm_g[i, 0]), shc, scc)
                yc = fourier_mix(hc, w_fourier[j])
        else:
            hc = modulate(rmsnorm(ctx, norm_g[i, 0]), shc, scc)
            p = (w_rnn_in[j], conv_w[j], conv_b[j], w_a[j], b_a[j], w_i[j], b_i[j], lam[j])
            hf_c, hb_c, gate_c = rglru_branch(hc, *p, None, None)
            hf_x, hb_x, gate_x = rglru_branch(hx, *p, hf_c[:, -1], hb_c[:, 0])
            yx = rglru_readout(hf_x, hb_x, gate_x, w_rnn_out[j])
            if not last:
                yc = rglru_readout(hf_c, hb_c, gate_c, w_rnn_out[j])
        x = x + gx * yx
        x = x + gx2 * sq_relu_mlp(modulate(rmsnorm(x, norm_g[i, 1]), shx2, scx2), w1[i], b1[i], w2[i], b2[i])
        if not last:
            ctx = ctx + gc * yc
            ctx = ctx + gc2 * sq_relu_mlp(modulate(rmsnorm(ctx, norm_g[i, 1]), shc2, scc2), w1[i], b1[i], w2[i], b2[i])
    return rmsnorm(x, final_g)
```

```cpp
#include <hip/hip_runtime.h>
#include <hip/hip_cooperative_groups.h>
#include <cstdio>
namespace cg = cooperative_groups;
#ifndef DUP_PREP
#define DUP_PREP 0
#endif
#ifndef DUP_SYNC
#define DUP_SYNC 0
#endif
#ifndef DUP_SCAN
#define DUP_SCAN 0
#endif
#ifndef DUP_NORM
#define DUP_NORM 0
#endif
#ifndef DUP_UP
#define DUP_UP 0
#endif
#ifndef DUP_DFT
#define DUP_DFT 0
#endif

#define LAS __attribute__((address_space(3)))
#define CAS __attribute__((address_space(4)))
typedef unsigned short bf16_t;
typedef short bf16x8 __attribute__((ext_vector_type(8)));
typedef float f32x4 __attribute__((ext_vector_type(4)));
typedef float f32x2 __attribute__((ext_vector_type(2)));
typedef unsigned u32x4 __attribute__((ext_vector_type(4)));
typedef unsigned u32x2 __attribute__((ext_vector_type(2)));

constexpr int DM = 1024, NB = 32, SEQL = 2048, CTXL = 256, NLAT = NB * SEQL, NCTX = NB * CTXL, NTOK = NLAT + NCTX;
constexpr int DFF = 4096, DR = 1344, RBK = 84, UW = 2816, VK = 1408, XOFF = 1408, MODW = 24576;
constexpr int BM = 256, BK = 64, HALF = 128, HTB = HALF * BK * 2, STAGE_BYTES = 8 * HTB, NXCD = 8, WGM = 8;
constexpr int LDS_BYTES = STAGE_BYTES + 16;

constexpr size_t WS_XB = 0;
constexpr size_t WS_HBUF = WS_XB + (size_t)NTOK * DM * 2;
constexpr size_t WS_BIG = WS_HBUF + (size_t)NTOK * DR * 2;
constexpr size_t WS_W1T = WS_BIG + (size_t)NTOK * DFF * 2;
constexpr size_t WS_W2T = WS_W1T + (size_t)4 * DFF * DM * 2;
constexpr size_t WS_WFT = WS_W2T + (size_t)4 * DFF * DM * 2;
constexpr size_t WS_WINT = WS_WFT + (size_t)2 * DM * DM * 2;
constexpr size_t WS_WOT = WS_WINT + (size_t)2 * UW * DM * 2;
constexpr size_t WS_FT = WS_WOT + (size_t)2 * DM * VK * 2;
constexpr size_t WS_FTC = WS_FT + (size_t)SEQL * 2 * SEQL * 2;
constexpr size_t WS_FC = WS_FTC + (size_t)CTXL * 2 * CTXL * 2;
constexpr size_t WS_AMOD = WS_FC + (size_t)512 * 256 * 2;
constexpr size_t WS_MOD = WS_AMOD + (size_t)256 * DM * 2;
constexpr size_t WS_BAR = WS_MOD + (size_t)33 * MODW * 4;
constexpr size_t WS_WG = WS_BAR + 16384;
constexpr size_t WG_IMG = 192 * 208;
constexpr size_t WS_END = WS_WG + (size_t)2 * 2 * 16 * WG_IMG;
static_assert(WS_END <= ((size_t)1 << 30), "workspace");
constexpr size_t BIG_PQTC = (size_t)NB * 1024 * 4096 * 2;

struct Args {
    const float *x, *c, *ctx, *c_ctx, *w_mod, *b_mod, *norm_g, *w_fourier, *w_rnn_in, *conv_w, *conv_b, *w_a, *b_a, *w_i, *b_i, *lam, *w_rnn_out, *w1, *b1, *w2, *b2, *final_g;
    float* out; unsigned char* ws;
};
typedef const CAS Args* ArgsP;
__device__ __forceinline__ ArgsP kargs() { ArgsP p = (ArgsP)__builtin_amdgcn_kernarg_segment_ptr(); asm volatile("" : "+s"(p)); return p; }

__device__ __forceinline__ unsigned cvt_pk_bf16(float lo, float hi) { unsigned r; asm volatile("v_cvt_pk_bf16_f32 %0, %1, %2" : "=v"(r) : "v"(lo), "v"(hi)); return r; }
__device__ __forceinline__ float bf_lo(unsigned w) { return __uint_as_float(w << 16); }
__device__ __forceinline__ float bf_hi(unsigned w) { return __uint_as_float(w & 0xffff0000u); }
__device__ __forceinline__ int otid() { int t = threadIdx.x; asm volatile("" : "+v"(t)); return t; }
__device__ __forceinline__ int obid() { int t = blockIdx.x; asm volatile("" : "+s"(t)); return t; }
__device__ __forceinline__ int ogrid() { int t = gridDim.x; asm volatile("" : "+s"(t)); return t; }
__device__ __forceinline__ float wave_sum(float v) {
#pragma unroll
    for (int o = 1; o < 64; o <<= 1) v += __shfl_xor(v, o);
    return v;
}


#define XB_TMO      128
#define XB_XCNT(j)  (256  + 64 * (j))
#define XB_XSUB(j)  (1280 + 64 * (j))
#define XB_XGEN(j)  (2304 + 64 * (j))
#define XB_TOP      3328
#define XB_TOPGEN   3392
#define XCD_BAR_WORDS 3456
#define XB_SPIN_CAP (1u << 20)
__device__ __forceinline__ unsigned xb_ld(unsigned* p)              { return __hip_atomic_load(p, __ATOMIC_RELAXED, __HIP_MEMORY_SCOPE_AGENT); }
__device__ __forceinline__ unsigned xb_add(unsigned* p, unsigned v) { return __hip_atomic_fetch_add(p, v, __ATOMIC_RELAXED, __HIP_MEMORY_SCOPE_AGENT); }
__device__ __forceinline__ unsigned xb_xcc_id() { return (unsigned)__builtin_amdgcn_s_getreg((3 << 11) | 20) & 0xFu; }
#define XB_SPIN(cond, bar) do { unsigned _sp = 0; while (cond) { __builtin_amdgcn_s_sleep(1); \
    if ((++_sp & 255u) == 0u) { if (xb_ld(&(bar)[XB_TMO])) break; if (_sp > XB_SPIN_CAP) { atomicAdd(&(bar)[XB_TMO], 1u); break; } } } } while (0)
__device__ __forceinline__ void xcd_barrier_complete(unsigned* bar, unsigned x, unsigned& nloc, unsigned& nx) {
    const unsigned G = gridDim.x;
    unsigned sum, cnt, mine, sp = 0u;
    for (;;) {
        sum = 0u; cnt = 0u; mine = 0u;
#pragma unroll
        for (unsigned j = 0; j < 16; ++j) { const unsigned c = xb_ld(&bar[XB_XCNT(j)]); sum += c; cnt += (c > 0u) ? 1u : 0u; mine = (j == x) ? c : mine; }
        if (sum == G) break;
        __builtin_amdgcn_s_sleep(1);
        if ((++sp & 255u) == 0u) { if (xb_ld(&bar[XB_TMO])) break; if (sp > XB_SPIN_CAP) { atomicAdd(&bar[XB_TMO], 1u); break; } }
    }
    nloc = mine > 0u ? mine : 1u; nx = cnt > 0u ? cnt : 1u;
}
__device__ __forceinline__ void xcd_barrier(unsigned* bar, volatile LAS unsigned* st) {
    asm volatile("s_waitcnt vmcnt(0)" ::: "memory");
    __syncthreads();
    if (threadIdx.x == 0) {
        const unsigned x = xb_xcc_id();
        __builtin_amdgcn_s_waitcnt(0);
        unsigned nloc = st[0], nx = st[1];
        if (nloc == 0u) { xcd_barrier_complete(bar, x, nloc, nx); st[0] = nloc; st[1] = nx; }
        const unsigned old = xb_add(&bar[XB_XSUB(x)], 1u);
        const unsigned gen = old / nloc;
        if (old + 1u == (gen + 1u) * nloc) {
            __builtin_amdgcn_fence(__ATOMIC_RELEASE, "agent");
            asm volatile("s_waitcnt vmcnt(0)" ::: "memory");
            const unsigned og = xb_add(&bar[XB_TOP], 1u);
            const unsigned tg = og / nx;
            if (og + 1u == (tg + 1u) * nx) xb_add(&bar[XB_TOPGEN], 1u);
            else XB_SPIN(xb_ld(&bar[XB_TOPGEN]) == tg, bar);
            __builtin_amdgcn_fence(__ATOMIC_ACQUIRE, "agent");
            xb_add(&bar[XB_XGEN(x)], 1u);
            asm volatile("s_waitcnt vmcnt(0)" ::: "memory");
        } else {
            XB_SPIN(xb_ld(&bar[XB_XGEN(x)]) == gen, bar);
            __builtin_amdgcn_fence(__ATOMIC_ACQUIRE, "agent");
            asm volatile("s_waitcnt vmcnt(0)" ::: "memory");
        }
    }
    __syncthreads();
}

__device__ __forceinline__ int lds_byte(int r, int c) { const int st = (r >> 4) * 2 + (c >> 5), rr = r & 15, cc = c & 31, ob = rr * 64 + cc * 2; return st * 1024 + (ob ^ (((ob >> 9) & 1) << 5)); }
__device__ __forceinline__ void stage_rc(int b, int& R, int& C) { const int st = b / 1024, sb = b % 1024, swz = sb ^ (((sb >> 9) & 1) << 5); R = (st >> 1) * 16 + swz / 64; C = (st & 1) * 32 + (swz % 64) / 2; }
__device__ __forceinline__ int perm32(int rho) { const int n = rho >> 4, i = rho & 15; return 8 * (i >> 2) + 4 * n + (i & 3); }

struct Unit { int pm, pn, z, hs; };
struct GemmDesc {
    const bf16_t* A; const bf16_t* Bt;
    int a_s1, a_s2, b_s1, b_s2;
    int lda, ldb, K, nM, nN, nZ, zdiv;
    int mode;
    bf16_t* Cb; int c_s1, c_s2, c_spm; int ldc; int act;
    const float* bias;
    const float *xs32_lat, *xs32_ctx; bf16_t* xb; const float* gate;
    float* Cf; int mrows; int pm_off, halfn;
};

__device__ __forceinline__ bool unit_at(const GemmDesc& g, int i, int G, int c, Unit& u) {
    const int nNe = g.halfn ? 2 * g.nN : g.nN; const int per = g.nM * nNe, nwg = per * g.nZ;
    const long L = (long)i * G + c; if (L >= nwg) return false;
    int wgid = (int)L; { const int q = nwg / NXCD, r = nwg % NXCD, xcd = wgid % NXCD, off = wgid / NXCD; wgid = (xcd < r ? xcd * (q + 1) : r * (q + 1) + (xcd - r) * q) + off; }
    u.z = wgid / per; const int w = wgid % per;
    const int nig = WGM * nNe, gid = w / nig, fm = gid * WGM, gsz = (g.nM - fm) < WGM ? (g.nM - fm) : WGM;
    u.pm = fm + ((w % nig) % gsz); const int pne = (w % nig) / gsz; u.hs = g.halfn ? (pne & 1) : 0; u.pn = g.halfn ? (pne >> 1) : pne; return true;
}

__device__ __forceinline__ void epilogue(const GemmDesc& g, const f32x4 (&acc)[2][2][4][2], const Unit& u) {
    const int tid_e = otid(), wid_e = tid_e >> 6, lane_e = tid_e & 63, wr = wid_e >> 2, wc = wid_e & 3, fr = lane_e & 15, fq = lane_e >> 4;
    if (g.mode == 0) {
        bf16_t* base = g.Cb + (long)((u.z / g.zdiv) * g.c_s1 + (u.z % g.zdiv) * g.c_s2 + u.pm * g.c_spm + u.pn * BM);
        const int rl0 = wr * 64 + fr, cl0 = wc * 64 + 8 * fq;
        f32x4 bv[2][2];
#pragma unroll
        for (int bj = 0; bj < 2; ++bj)
#pragma unroll
            for (int n = 0; n < 2; ++n) bv[bj][n] = g.bias ? *(const f32x4*)(g.bias + u.pn * BM + cl0 + bj * 32 + 4 * n) : (f32x4){0.f, 0.f, 0.f, 0.f};
#pragma unroll
        for (int ai = 0; ai < 2; ++ai)
#pragma unroll
            for (int m = 0; m < 4; ++m) { bf16_t* rowp = base + (long)(rl0 + ai * HALF + m * 16) * g.ldc + cl0;
#pragma unroll
                for (int bj = 0; bj < 2; ++bj) { f32x4 v0 = acc[ai][bj][m][0] + bv[bj][0], v1 = acc[ai][bj][m][1] + bv[bj][1];
                    if (g.act == 1) {
#pragma unroll
                        for (int j = 0; j < 4; ++j) { float t0 = fmaxf(v0[j], 0.f), t1 = fmaxf(v1[j], 0.f); v0[j] = t0 * t0; v1[j] = t1 * t1; } }
                    else if (g.act == 2 && (u.pn * BM + cl0 + bj * 32) < XOFF) {
#pragma unroll
                        for (int j = 0; j < 4; ++j) { const float a0 = v0[j], a1 = v1[j];
                            v0[j] = a0 * __builtin_amdgcn_rcpf(1.f + __builtin_amdgcn_exp2f(a0 * (-2.3022082f + -0.10294324f * a0 * a0)));
                            v1[j] = a1 * __builtin_amdgcn_rcpf(1.f + __builtin_amdgcn_exp2f(a1 * (-2.3022082f + -0.10294324f * a1 * a1))); } }
                    u32x4 w; w.x = cvt_pk_bf16(v0[0], v0[1]); w.y = cvt_pk_bf16(v0[2], v0[3]); w.z = cvt_pk_bf16(v1[0], v1[1]); w.w = cvt_pk_bf16(v1[2], v1[3]);
                    *(u32x4*)(rowp + bj * 32) = w;
                    if (g.act == 3) {
                        const int k = u.pm * BM + rl0 + ai * HALF + m * 16;
                        if (k >= 1) { const int l0 = cl0 + bj * 32;
                            bf16_t* mrow = g.Cb + (long)(u.z * g.c_s1 + (SEQL - k) * g.ldc + u.pn * BM);
                            mrow[(256 - l0) & 255] = (bf16_t)(w.x & 0xffffu);
                            *(unsigned*)(mrow + 254 - l0) = cvt_pk_bf16(v0[2], v0[1]);
                            *(unsigned*)(mrow + 252 - l0) = cvt_pk_bf16(v1[0], v0[3]);
                            *(unsigned*)(mrow + 250 - l0) = cvt_pk_bf16(v1[2], v1[1]);
                            mrow[249 - l0] = (bf16_t)(w.w >> 16); } } }
                __builtin_amdgcn_sched_barrier(0); }
    } else if (g.mode == 1) {
        const int R0 = (u.pm + g.pm_off) * BM; const int rl0 = wr * 64 + fr, cl0 = u.pn * BM + wc * 64 + 8 * fq + u.hs * 32;
        const float* gate = g.gate + (size_t)(R0 < NLAT ? (R0 >> 11) : 32) * MODW;
        bf16_t* dst = g.xb + (size_t)R0 * DM;
        const float* src32 = g.xs32_lat ? (R0 < NLAT ? g.xs32_lat + (size_t)R0 * DM : g.xs32_ctx + (size_t)(R0 - NLAT) * DM) : nullptr;
#pragma unroll
        for (int bj = 0; bj < 2; ++bj) {
            if (bj == 1 && g.halfn) break;
            f32x4 gv0 = *(const f32x4*)(gate + cl0 + bj * 32), gv1 = *(const f32x4*)(gate + cl0 + bj * 32 + 4);
            f32x4 gb0 = (f32x4){0.f, 0.f, 0.f, 0.f}, gb1 = (f32x4){0.f, 0.f, 0.f, 0.f};
            if (g.bias) { gb0 = *(const f32x4*)(g.bias + cl0 + bj * 32); gb1 = *(const f32x4*)(g.bias + cl0 + bj * 32 + 4); }
            if (src32) {
                gb0 = gb0 * gv0; gb1 = gb1 * gv1;
#pragma unroll
                for (int ai = 0; ai < 2; ++ai)
#pragma unroll
                    for (int m = 0; m < 4; ++m) { const size_t ro = (size_t)(rl0 + ai * HALF + m * 16) * DM + cl0 + bj * 32;
                        const f32x4 x0 = *(const f32x4*)(src32 + ro), x1 = *(const f32x4*)(src32 + ro + 4);
                        const f32x4 y0 = x0 + (gv0 * acc[ai][bj][m][0] + gb0), y1 = x1 + (gv1 * acc[ai][bj][m][1] + gb1);
                        u32x4 w; w.x = cvt_pk_bf16(y0[0], y0[1]); w.y = cvt_pk_bf16(y0[2], y0[3]); w.z = cvt_pk_bf16(y1[0], y1[1]); w.w = cvt_pk_bf16(y1[2], y1[3]);
                        *(u32x4*)(dst + ro) = w;
                        if (m & 1) __builtin_amdgcn_sched_barrier(0); }
            } else {
#pragma unroll
                for (int ai = 0; ai < 2; ++ai) {
                    u32x4 xw[4];
#pragma unroll
                    for (int m = 0; m < 4; ++m) xw[m] = *(const u32x4*)(dst + (size_t)(rl0 + ai * HALF + m * 16) * DM + cl0 + bj * 32);
                    __builtin_amdgcn_sched_barrier(0);
                    if (ai == 0) { gb0 = gb0 * gv0; gb1 = gb1 * gv1; }
#pragma unroll
                    for (int m = 0; m < 4; ++m) { const size_t ro = (size_t)(rl0 + ai * HALF + m * 16) * DM + cl0 + bj * 32; const u32x4 q = xw[m];
                        const f32x4 x0 = (f32x4){bf_lo(q.x), bf_hi(q.x), bf_lo(q.y), bf_hi(q.y)}, x1 = (f32x4){bf_lo(q.z), bf_hi(q.z), bf_lo(q.w), bf_hi(q.w)};
                        const f32x4 y0 = x0 + (gv0 * acc[ai][bj][m][0] + gb0), y1 = x1 + (gv1 * acc[ai][bj][m][1] + gb1);
                        u32x4 w; w.x = cvt_pk_bf16(y0[0], y0[1]); w.y = cvt_pk_bf16(y0[2], y0[3]); w.z = cvt_pk_bf16(y1[0], y1[1]); w.w = cvt_pk_bf16(y1[2], y1[3]);
                        *(u32x4*)(dst + ro) = w; }
                    __builtin_amdgcn_sched_barrier(0); }
            }
        }
    } else {
        const int R0 = u.pm * BM; const int col0 = u.pn * BM + wc * 32 + 4 * fq; const int rl0 = wr * 64 + fr;
        f32x4 bv[2][2];
#pragma unroll
        for (int bj = 0; bj < 2; ++bj)
#pragma unroll
            for (int n = 0; n < 2; ++n) bv[bj][n] = g.bias ? *(const f32x4*)(g.bias + col0 + bj * HALF + n * 16) : (f32x4){0.f, 0.f, 0.f, 0.f};
#pragma unroll
        for (int ai = 0; ai < 2; ++ai)
#pragma unroll
            for (int m = 0; m < 4; ++m) { const int r = R0 + rl0 + ai * HALF + m * 16;
                if (r < g.mrows) { float* rowp = g.Cf + (size_t)r * g.ldc + col0;
#pragma unroll
                    for (int bj = 0; bj < 2; ++bj)
#pragma unroll
                        for (int n = 0; n < 2; ++n) *(f32x4*)(rowp + bj * HALF + n * 16) = acc[ai][bj][m][n] + bv[bj][n]; } }
    }
}

__device__ __forceinline__ void gemm_phase(LAS unsigned char* lds, const GemmDesc& g) {
    const int tid = otid(), wid = __builtin_amdgcn_readfirstlane(tid >> 6), lane = tid & 63, wr = wid >> 2, wc = wid & 3, fr = lane & 15, fq = lane >> 4;
    const int nt = g.K / BK; const int G = ogrid(), cblk = obid();
    const bool perm = (g.mode != 2); const bool fulln = (g.halfn == 0);
    unsigned voffA[2], voffB[2];
#pragma unroll
    for (int i = 0; i < 2; ++i) { int R, C; stage_rc(tid * 16 + i * 8192, R, C); const int Rb = perm ? (64 * (R >> 5) + perm32(R & 31)) : R;
        voffA[i] = (unsigned)(R * g.lda + C) * 2u; voffB[i] = (unsigned)(Rb * g.ldb + C) * 2u; }
    const size_t kstep = (size_t)(BK * 2);
    const size_t hstepA = (size_t)HALF * g.lda * 2, hstepB = (size_t)(perm ? 32 : HALF) * g.ldb * 2;
    const unsigned ldsw = (unsigned)wid * 1024u;
    const int aoff = lds_byte(wr * 64 + fr, fq * 8), boff = lds_byte(wc * 32 + fr, fq * 8);
#define PG8_SA(b, h) (((b) * 2 + (h)) * HTB)
#define PG8_SB(b, h) ((4 + (b) * 2 + (h)) * HTB)
#define PG8_STAGE(bufoff, gbase, voff) do { _Pragma("unroll") for (int _i = 0; _i < 2; ++_i) \
        __builtin_amdgcn_global_load_lds((const unsigned*)((const char*)(gbase) + (voff)[_i]), (LAS unsigned*)(lds + (bufoff) + ldsw + _i * 8192), 16, 0, 0); } while (0)
#define PG8_LDA(dst, b, h) do { _Pragma("unroll") for (int m = 0; m < 4; ++m) _Pragma("unroll") for (int k = 0; k < 2; ++k) dst[m][k] = *(const LAS bf16x8*)(lds + PG8_SA(b, h) + aoff + m * 2048 + k * 1024); } while (0)
#define PG8_LDB(dst, b, h) do { _Pragma("unroll") for (int n = 0; n < 2; ++n) _Pragma("unroll") for (int k = 0; k < 2; ++k) dst[n][k] = *(const LAS bf16x8*)(lds + PG8_SB(b, h) + boff + n * 2048 + k * 1024); } while (0)
#define PG8_MMA(ai, bj, At, Bt) do { __builtin_amdgcn_s_setprio(1); _Pragma("unroll") for (int m = 0; m < 4; ++m) _Pragma("unroll") for (int n = 0; n < 2; ++n) _Pragma("unroll") for (int k = 0; k < 2; ++k) \
        acc[ai][bj][m][n] = __builtin_amdgcn_mfma_f32_16x16x32_bf16(Bt[n][k], At[m][k], acc[ai][bj][m][n], 0, 0, 0); __builtin_amdgcn_s_setprio(0); } while (0)
#define PG8_WAIT_V(n) asm volatile("s_waitcnt vmcnt(" #n ")" ::: "memory")
#define PG8_WAIT_L(n) asm volatile("s_waitcnt lgkmcnt(" #n ")" ::: "memory")
#define PG8_BAR __builtin_amdgcn_s_barrier()
#define PG8_SCHED __builtin_amdgcn_sched_barrier(0)
    Unit cur, nxt; int ui = 0;
    if (!unit_at(g, 0, G, cblk, cur)) return;
    f32x4 acc[2][2][4][2];
#pragma unroll
    for (int a = 0; a < 2; ++a)
#pragma unroll
        for (int b = 0; b < 2; ++b)
#pragma unroll
            for (int m = 0; m < 4; ++m)
#pragma unroll
                for (int n = 0; n < 2; ++n) acc[a][b][m][n] = (f32x4){0.f, 0.f, 0.f, 0.f};
    bf16x8 At[4][2], B0[2][2], B1[2][2];
    const char* cA = (const char*)(g.A + (long)((cur.z / g.zdiv) * g.a_s1 + (cur.z % g.zdiv) * g.a_s2 + cur.pm * BM * g.lda));
    const char* cB = (const char*)(g.Bt + (long)((cur.z / g.zdiv) * g.b_s1 + (cur.z % g.zdiv) * g.b_s2 + (cur.pn * BM + cur.hs * 32) * g.ldb));
    PG8_STAGE(PG8_SB(0, 0), cB, voffB); PG8_STAGE(PG8_SA(0, 0), cA, voffA); PG8_STAGE(PG8_SB(0, 1), cB + hstepB, voffB); PG8_STAGE(PG8_SA(0, 1), cA + hstepA, voffA);
    if (wr == 1) PG8_BAR;
    PG8_WAIT_V(4); PG8_BAR;
    PG8_STAGE(PG8_SB(1, 0), cB + kstep, voffB); PG8_STAGE(PG8_SA(1, 0), cA + kstep, voffA); PG8_STAGE(PG8_SB(1, 1), cB + hstepB + kstep, voffB);
    PG8_WAIT_V(6); PG8_BAR;
    for (;;) {
        const bool has_next = unit_at(g, ui + 1, G, cblk, nxt);
        const char* nA = has_next ? (const char*)(g.A + (long)((nxt.z / g.zdiv) * g.a_s1 + (nxt.z % g.zdiv) * g.a_s2 + nxt.pm * BM * g.lda)) : cA;
        const char* nB = has_next ? (const char*)(g.Bt + (long)((nxt.z / g.zdiv) * g.b_s1 + (nxt.z % g.zdiv) * g.b_s2 + (nxt.pn * BM + nxt.hs * 32) * g.ldb)) : cB;
        for (int t = 0; t < nt; t += 2) {
            const bool last = (t == nt - 2);
            const char* a1 = cA + (size_t)(t + 1) * kstep;
            const char* a2 = last ? nA : cA + (size_t)(t + 2) * kstep; const char* b2 = last ? nB : cB + (size_t)(t + 2) * kstep;
            const char* a3 = a2 + kstep; const char* b3 = b2 + kstep;
            PG8_LDB(B0, 0, 0); PG8_SCHED; PG8_LDA(At, 0, 0); PG8_STAGE(PG8_SA(1, 1), a1 + hstepA, voffA);
            PG8_WAIT_L(8); PG8_BAR; PG8_WAIT_L(0); PG8_MMA(0, 0, At, B0); PG8_BAR; PG8_SCHED;
            if (fulln) PG8_LDB(B1, 0, 1); PG8_STAGE(PG8_SB(0, 0), b2, voffB);
            PG8_BAR; PG8_WAIT_L(0); if (fulln) PG8_MMA(0, 1, At, B1); PG8_BAR;
            PG8_LDA(At, 0, 1); PG8_STAGE(PG8_SA(0, 0), a2, voffA);
            PG8_BAR; PG8_WAIT_L(0); PG8_MMA(1, 0, At, B0); PG8_BAR; PG8_SCHED;
            PG8_STAGE(PG8_SB(0, 1), b2 + hstepB, voffB);
            PG8_WAIT_V(6); PG8_BAR; if (fulln) PG8_MMA(1, 1, At, B1); PG8_BAR;
            PG8_LDB(B0, 1, 0); PG8_SCHED; PG8_LDA(At, 1, 0); PG8_STAGE(PG8_SA(0, 1), a2 + hstepA, voffA);
            PG8_WAIT_L(8); PG8_BAR; PG8_WAIT_L(0); PG8_MMA(0, 0, At, B0); PG8_BAR; PG8_SCHED;
            if (fulln) PG8_LDB(B1, 1, 1); PG8_STAGE(PG8_SB(1, 0), b3, voffB);
            PG8_BAR; PG8_WAIT_L(0); if (fulln) PG8_MMA(0, 1, At, B1); PG8_BAR;
            PG8_LDA(At, 1, 1); PG8_STAGE(PG8_SA(1, 0), a3, voffA);
            PG8_BAR; PG8_WAIT_L(0); PG8_MMA(1, 0, At, B0); PG8_BAR; PG8_SCHED;
            PG8_STAGE(PG8_SB(1, 1), b3 + hstepB, voffB);
            PG8_WAIT_V(6); PG8_BAR; if (fulln) PG8_MMA(1, 1, At, B1); PG8_BAR;
        }
        epilogue(g, acc, cur);
        if (!has_next) break;
#pragma unroll
        for (int a = 0; a < 2; ++a)
#pragma unroll
            for (int b = 0; b < 2; ++b)
#pragma unroll
                for (int m = 0; m < 4; ++m)
#pragma unroll
                    for (int n = 0; n < 2; ++n) acc[a][b][m][n] = (f32x4){0.f, 0.f, 0.f, 0.f};
        cur = nxt; cA = nA; cB = nB; ++ui;
    }
    PG8_WAIT_V(0);
    if (wr == 0) PG8_BAR;
    PG8_BAR;
#undef PG8_SA
#undef PG8_SB
#undef PG8_STAGE
#undef PG8_LDA
#undef PG8_LDB
#undef PG8_MMA
#undef PG8_WAIT_V
#undef PG8_WAIT_L
#undef PG8_BAR
#undef PG8_SCHED
}

__device__ __forceinline__ void transpose_item(const float* W, int N, bf16_t* WT, int ldk, int row_off, LAS float* scr, int kb, int nb, int lane) {
    const int k0 = 64 * kb, n0 = 32 * nb;
    float tv[32];
#pragma unroll
    for (int i = 0; i < 32; ++i) tv[i] = W[(size_t)(k0 + 2 * i + (lane >> 5)) * N + n0 + (lane & 31)];
#pragma unroll
    for (int i = 0; i < 32; ++i) scr[(2 * i + (lane >> 5)) * 33 + (lane & 31)] = tv[i];
    asm volatile("s_waitcnt lgkmcnt(0)" ::: "memory");
    const int c = lane & 7;
#pragma unroll
    for (int j = 0; j < 4; ++j) { const int n = (lane >> 3) + 8 * j; const LAS float* s = scr + (8 * c) * 33 + n;
        u32x4 o; o.x = cvt_pk_bf16(s[0 * 33], s[1 * 33]); o.y = cvt_pk_bf16(s[2 * 33], s[3 * 33]); o.z = cvt_pk_bf16(s[4 * 33], s[5 * 33]); o.w = cvt_pk_bf16(s[6 * 33], s[7 * 33]);
        *(u32x4*)(WT + (size_t)(row_off + n0 + n) * ldk + k0 + 8 * c) = o; }
    asm volatile("s_waitcnt lgkmcnt(0)" ::: "memory");
}

__device__ __forceinline__ float silu_f(float v) { return v / (1.f + __expf(-v)); }

__device__ __forceinline__ void prep_phase(LAS unsigned char* lds, ArgsP a) {
    const int tid = otid(), wave = tid >> 6, lane = tid & 63; const int bid = obid(), gsz = ogrid();
    LAS float* scr = (LAS float*)(lds + wave * 16384);
    bf16_t* w1t = (bf16_t*)(a->ws + WS_W1T); bf16_t* w2t = (bf16_t*)(a->ws + WS_W2T); bf16_t* wft = (bf16_t*)(a->ws + WS_WFT);
    bf16_t* wint = (bf16_t*)(a->ws + WS_WINT); bf16_t* wot = (bf16_t*)(a->ws + WS_WOT); bf16_t* wmodt = (bf16_t*)(a->ws + WS_BIG);
    const int gw = bid * 8 + wave, NGW = gsz * 8;
    constexpr int I_W1 = 2048, I_W2 = 2048, I_WF = 512, I_WIN = 1344, I_WOUT = 672, I_WMOD = 3072;
    constexpr int NITEMS = 4 * I_W1 + 4 * I_W2 + 2 * I_WF + 2 * I_WIN + 2 * I_WOUT + 4 * I_WMOD;
    for (int it = gw; it < NITEMS; it += NGW) {
        int r = it;
        if (r < 4 * I_W1) { const int l = r / I_W1, q = r % I_W1; transpose_item(a->w1 + (size_t)l * DM * DFF, DFF, w1t + (size_t)l * DFF * DM, DM, 0, scr, q / 128, q % 128, lane); continue; } r -= 4 * I_W1;
        if (r < 4 * I_W2) { const int l = r / I_W2, q = r % I_W2; transpose_item(a->w2 + (size_t)l * DFF * DM, DM, w2t + (size_t)l * DM * DFF, DFF, 0, scr, q / 32, q % 32, lane); continue; } r -= 4 * I_W2;
        if (r < 2 * I_WF) { const int l = r / I_WF, q = r % I_WF; transpose_item(a->w_fourier + (size_t)l * DM * DM, DM, wft + (size_t)l * DM * DM, DM, 0, scr, q / 32, q % 32, lane); continue; } r -= 2 * I_WF;
        if (r < 2 * I_WIN) { const int l = r / I_WIN, q = r % I_WIN; const int nb = q % 84;
            transpose_item(a->w_rnn_in + (size_t)l * DM * 2 * DR, 2 * DR, wint + (size_t)l * UW * DM, DM, nb >= 42 ? 64 : 0, scr, q / 84, nb, lane); continue; } r -= 2 * I_WIN;
        if (r < 2 * I_WOUT) { const int l = r / I_WOUT, q = r % I_WOUT; transpose_item(a->w_rnn_out + (size_t)l * DR * DM, DM, wot + (size_t)l * DM * VK, VK, 0, scr, q / 32, q % 32, lane); continue; } r -= 2 * I_WOUT;
        { const int l = r / I_WMOD, q = r % I_WMOD; transpose_item(a->w_mod + (size_t)l * DM * 6 * DM, 6 * DM, wmodt + (size_t)l * 6 * DM * DM, DM, 0, scr, q / 192, q % 192, lane); }
    }
    const size_t gt = (size_t)bid * 512 + tid, GT = (size_t)gsz * 512;
    unsigned* ft = (unsigned*)(a->ws + WS_FT);
    for (size_t i = gt; i < (size_t)SEQL * SEQL * 2 / 2; i += GT) {
        const int k = (int)(i / 2048), col = (int)(i % 2048) * 2, cs = col >> 11, t = col & 2047; float v[2];
#pragma unroll
        for (int e = 0; e < 2; ++e) { const float ang = (float)((k * (t + e)) & 2047) * (1.f / 1024.f); v[e] = (cs == 0 ? cospif(ang) : -sinpif(ang)) * 0.02209708691207961f; }
        ft[i] = cvt_pk_bf16(v[0], v[1]);
    }
    unsigned* ftc = (unsigned*)(a->ws + WS_FTC);
    for (size_t i = gt; i < (size_t)CTXL * CTXL * 2 / 2; i += GT) {
        const int k = (int)(i / 256), col = (int)(i % 256) * 2, cs = col >> 8, t = col & 255; float v[2];
#pragma unroll
        for (int e = 0; e < 2; ++e) { const float ang = (float)((k * (t + e)) & 255) * (1.f / 128.f); v[e] = (cs == 0 ? cospif(ang) : -sinpif(ang)) * 0.0625f; }
        ftc[i] = cvt_pk_bf16(v[0], v[1]);
    }
    unsigned* fc = (unsigned*)(a->ws + WS_FC);
    for (size_t i = gt; i < (size_t)512 * 256 / 2; i += GT) {
        const int m = (int)(i / 128), col = (int)(i % 128) * 2, cs = m >> 8, l = m & 255; float v[2];
#pragma unroll
        for (int e = 0; e < 2; ++e) { const float ang = (float)((l * (col + e)) & 255) * (1.f / 128.f); v[e] = (cs == 0 ? cospif(ang) : sinpif(ang)) * 0.0625f; }
        fc[i] = cvt_pk_bf16(v[0], v[1]);
    }
    unsigned* amod = (unsigned*)(a->ws + WS_AMOD);
    for (size_t i = gt; i < (size_t)256 * DM / 2; i += GT) {
        const int row = (int)(i / 512), col = (int)(i % 512) * 2; float v0 = 0.f, v1 = 0.f;
        if (row < 32) { v0 = silu_f(a->c[row * DM + col]); v1 = silu_f(a->c[row * DM + col + 1]); }
        else if (row == 32) { v0 = silu_f(a->c_ctx[col]); v1 = silu_f(a->c_ctx[col + 1]); }
        amod[i] = cvt_pk_bf16(v0, v1);
    }
    { unsigned* wgi = (unsigned*)(a->ws + WS_WG);
      for (size_t i = gt; i < (size_t)2 * 2 * 16 * 192 * 52; i += GT) {
          const int kp = (int)(i % 52), row = (int)((i / 52) % 192), blk = (int)(i / (52 * 192));
          const int part = row / 96, jo = row % 96, k0 = kp * 2; float v0 = 0.f, v1 = 0.f;
          if (jo < RBK) { const float* w = (part ? a->w_i : a->w_a) + (size_t)blk * RBK * RBK; if (k0 < RBK) v0 = w[(size_t)k0 * RBK + jo]; if (k0 + 1 < RBK) v1 = w[(size_t)(k0 + 1) * RBK + jo]; }
          wgi[i] = cvt_pk_bf16(-1.4426950408889634f * v0, -1.4426950408889634f * v1); } }
    for (size_t i = gt; i < (size_t)2 * 128 * DM / 2; i += GT) {
        const int l = (int)(i / (128 * 512)), rr = (int)((i / 512) % 128), cw = (int)(i % 512);
        const int row = rr < 64 ? 1344 + rr : 2752 + (rr - 64);
        ((unsigned*)(wint + (size_t)l * UW * DM + (size_t)row * DM))[cw] = 0u;
    }
    for (size_t i = gt; i < (size_t)2 * DM * 32; i += GT) {
        const int l = (int)(i / (DM * 32)), row = (int)((i / 32) % DM), cw = (int)(i % 32);
        ((unsigned*)(wot + (size_t)l * DM * VK + (size_t)row * VK + DR))[cw] = 0u;
    }
}

__device__ __forceinline__ void normmod_phase(ArgsP a, const float* xlat, const float* xctx, const float* g, const float* modl  , int shift_part, int nrows, bf16_t* hout) {
    const int tid = otid(); const int lane = tid & 63, gw = obid() * 8 + (tid >> 6), NGW = ogrid() * 8;
    const int rpw = (nrows + NGW - 1) / NGW; const int r0 = gw * rpw; int r1 = r0 + rpw; if (r1 > nrows) r1 = nrows;
    f32x4 ca[4], cb[4]; int curb = -1;
    f32x4 gv[4];
#pragma unroll
    for (int j = 0; j < 4; ++j) gv[j] = *(const f32x4*)(g + 4 * lane + 256 * j);
    f32x4 v[4], vn[4];
    if (r0 < r1) { const float* xr = r0 < NLAT ? xlat + (size_t)r0 * DM : xctx + (size_t)(r0 - NLAT) * DM;
#pragma unroll
        for (int j = 0; j < 4; ++j) vn[j] = *(const f32x4*)(xr + 4 * lane + 256 * j); }
    for (int r = r0; r < r1; ++r) {
#pragma unroll
        for (int j = 0; j < 4; ++j) v[j] = vn[j];
        if (r + 1 < r1) { const int rn = r + 1; const float* xr = rn < NLAT ? xlat + (size_t)rn * DM : xctx + (size_t)(rn - NLAT) * DM;
#pragma unroll
            for (int j = 0; j < 4; ++j) vn[j] = *(const f32x4*)(xr + 4 * lane + 256 * j); }
        const int bidx = r < NLAT ? (r >> 11) : 32;
        if (bidx != curb) { curb = bidx; const float* mp = modl + (size_t)bidx * MODW + shift_part * DM;
#pragma unroll
            for (int j = 0; j < 4; ++j) { const f32x4 sh = *(const f32x4*)(mp + 4 * lane + 256 * j), sc = *(const f32x4*)(mp + DM + 4 * lane + 256 * j); ca[j] = gv[j] * (sc + 1.f); cb[j] = sh; } }
        float s = 0.f;
#pragma unroll
        for (int j = 0; j < 4; ++j) s += (v[j].x * v[j].x + v[j].y * v[j].y) + (v[j].z * v[j].z + v[j].w * v[j].w);
        const float rstd = rsqrtf(wave_sum(s) * (1.f / DM) + 1e-6f);
        u32x2* o = (u32x2*)(hout + (size_t)r * DM) + lane;
#pragma unroll
        for (int j = 0; j < 4; ++j) { const f32x4 y = (v[j] * rstd) * ca[j] + cb[j]; u32x2 w; w.x = cvt_pk_bf16(y.x, y.y); w.y = cvt_pk_bf16(y.z, y.w); o[64 * j] = w; }
    }
}

__device__ __forceinline__ void normmod_bf16_phase(ArgsP a, const bf16_t* xb, const float* g, const float* modl, int shift_part, int nrows, bf16_t* hout) {
    const int tid = otid(); const int lane = tid & 63, gw = obid() * 8 + (tid >> 6), NGW = ogrid() * 8;
    const int rpw = (nrows + NGW - 1) / NGW; const int r0 = gw * rpw; int r1 = r0 + rpw; if (r1 > nrows) r1 = nrows;
    f32x4 ca[4], cb[4], gv[4]; int curb = -1;
#pragma unroll
    for (int j = 0; j < 4; ++j) gv[j] = *(const f32x4*)(g + 8 * lane + 512 * (j >> 1) + 4 * (j & 1));
    u32x4 wn[2] = {};
    if (r0 < r1) {
#pragma unroll
        for (int j = 0; j < 2; ++j) wn[j] = *(const u32x4*)(xb + (size_t)r0 * DM + 8 * lane + 512 * j); }
    for (int r = r0; r < r1; ++r) {
        f32x4 v[4];
#pragma unroll
        for (int j = 0; j < 2; ++j) { v[2 * j] = (f32x4){bf_lo(wn[j].x), bf_hi(wn[j].x), bf_lo(wn[j].y), bf_hi(wn[j].y)}; v[2 * j + 1] = (f32x4){bf_lo(wn[j].z), bf_hi(wn[j].z), bf_lo(wn[j].w), bf_hi(wn[j].w)}; }
        if (r + 1 < r1) {
#pragma unroll
            for (int j = 0; j < 2; ++j) wn[j] = *(const u32x4*)(xb + (size_t)(r + 1) * DM + 8 * lane + 512 * j); }
        const int bidx = r < NLAT ? (r >> 11) : 32;
        if (bidx != curb) { curb = bidx; const float* mp = modl + (size_t)bidx * MODW + shift_part * DM;
#pragma unroll
            for (int j = 0; j < 4; ++j) { const int co = 8 * lane + 512 * (j >> 1) + 4 * (j & 1); const f32x4 sh = *(const f32x4*)(mp + co), sc = *(const f32x4*)(mp + DM + co); ca[j] = gv[j] * (sc + 1.f); cb[j] = sh; } }
        float s = 0.f;
#pragma unroll
        for (int j = 0; j < 4; ++j) s += (v[j].x * v[j].x + v[j].y * v[j].y) + (v[j].z * v[j].z + v[j].w * v[j].w);
        const float rstd = rsqrtf(wave_sum(s) * (1.f / DM) + 1e-6f);
#pragma unroll
        for (int j = 0; j < 2; ++j) { const f32x4 y0 = (v[2 * j] * rstd) * ca[2 * j] + cb[2 * j], y1 = (v[2 * j + 1] * rstd) * ca[2 * j + 1] + cb[2 * j + 1];
            u32x4 w; w.x = cvt_pk_bf16(y0.x, y0.y); w.y = cvt_pk_bf16(y0.z, y0.w); w.z = cvt_pk_bf16(y1.x, y1.y); w.w = cvt_pk_bf16(y1.z, y1.w);
            *(u32x4*)(hout + (size_t)r * DM + 8 * lane + 512 * j) = w; }
    }
}

__device__ __forceinline__ void final_phase(ArgsP a) {
    const int tid = otid(); const int lane = tid & 63, gw = obid() * 8 + (tid >> 6), NGW = ogrid() * 8;
    const bf16_t* xb = (const bf16_t*)(a->ws + WS_XB);
    f32x4 gv[4];
#pragma unroll
    for (int j = 0; j < 4; ++j) gv[j] = *(const f32x4*)(a->final_g + 8 * lane + 512 * (j >> 1) + 4 * (j & 1));
    u32x4 wn[2] = {};
    if (gw < NLAT) {
#pragma unroll
        for (int j = 0; j < 2; ++j) wn[j] = *(const u32x4*)(xb + (size_t)gw * DM + 8 * lane + 512 * j); }
    for (int r = gw; r < NLAT; r += NGW) {
        f32x4 v[4]; float s = 0.f;
#pragma unroll
        for (int j = 0; j < 2; ++j) { const u32x4 w = wn[j];
            v[2 * j] = (f32x4){bf_lo(w.x), bf_hi(w.x), bf_lo(w.y), bf_hi(w.y)}; v[2 * j + 1] = (f32x4){bf_lo(w.z), bf_hi(w.z), bf_lo(w.w), bf_hi(w.w)}; }
        if (r + NGW < NLAT) {
#pragma unroll
            for (int j = 0; j < 2; ++j) wn[j] = *(const u32x4*)(xb + (size_t)(r + NGW) * DM + 8 * lane + 512 * j); }
#pragma unroll
        for (int j = 0; j < 4; ++j) s += (v[j].x * v[j].x + v[j].y * v[j].y) + (v[j].z * v[j].z + v[j].w * v[j].w);
        const float rstd = rsqrtf(wave_sum(s) * (1.f / DM) + 1e-6f);
        float* orow = a->out + (size_t)r * DM;
#pragma unroll
        for (int j = 0; j < 4; ++j) *(f32x4*)(orow + 8 * lane + 512 * (j >> 1) + 4 * (j & 1)) = (v[j] * rstd) * gv[j];
    }
}

__device__ __forceinline__ void dft_mid_row(ArgsP a) {
    const int tid = otid(); const int lane = tid & 63, gw = obid() * 8 + (tid >> 6), NGW = ogrid() * 8;
    const bf16_t* pqt = (const bf16_t*)(a->ws + WS_BIG); bf16_t* f = (bf16_t*)(a->ws + WS_HBUF);
    for (int row0 = gw * 4; row0 < NB * DM; row0 += NGW * 4) {
        u32x4 w[4][4];
#pragma unroll
        for (int rr = 0; rr < 4; ++rr) { const u32x4* src = (const u32x4*)(pqt + (size_t)(row0 + rr) * 4096) + lane;
#pragma unroll
            for (int j = 0; j < 4; ++j) w[rr][j] = src[64 * j]; }
#pragma unroll
        for (int rr = 0; rr < 4; ++rr) { float s = 0.f;
#pragma unroll
            for (int j = 0; j < 4; ++j) { const u32x4 q = w[rr][j]; s += (bf_lo(q.x) - bf_hi(q.x)) + (bf_lo(q.y) - bf_hi(q.y)) + (bf_lo(q.z) - bf_hi(q.z)) + (bf_lo(q.w) - bf_hi(q.w)); }
            s = wave_sum(s) * 0.02209708691207961f;
            if (lane == 0) { const int row = row0 + rr, b = row >> 10, c = row & 1023; f[((size_t)b * SEQL + SEQL / 2) * DM + c] = (bf16_t)(cvt_pk_bf16(s, 0.f) & 0xffffu); } }
    }
}

constexpr int SC_XRB = 0;
constexpr int SC_WG = SC_XRB + 66 * 208;
constexpr int SAS = 112, SBS = 100;
constexpr int SC_SA = SC_WG + 192 * 208;
constexpr int SC_SB = SC_SA + 2 * 16 * SAS * 4;
constexpr int SC_SX = SC_SB + 64 * SBS * 4;
constexpr int SC_END = SC_SX + 66 * SBS * 4;
static_assert(SC_END <= LDS_BYTES, "scan LDS");

__device__ __forceinline__ void scan_phase(LAS unsigned char* lds, ArgsP a, int j, bool store_v) {
    const int tid = otid(), wave = tid >> 6, lane = tid & 63, fr = lane & 15, fq = lane >> 4; const int bid = obid(), gsz = ogrid();
    bf16_t* u = (bf16_t*)(a->ws + WS_BIG); bf16_t* hf = (bf16_t*)(a->ws + WS_HBUF);
    LAS unsigned char* xrb = lds + SC_XRB; LAS unsigned char* wg = lds + SC_WG;
    LAS float* sa = (LAS float*)(lds + SC_SA); LAS float* sb = (LAS float*)(lds + SC_SB); LAS float* sx = (LAS float*)(lds + SC_SX);
    const int p = tid % 42, tg = tid / 42; const bool cthr = tid < 462;
    const int mt = wave & 3, half = wave >> 2;
    constexpr float L2E = 1.4426950408889634f;
    for (int item = bid; item < NB * 16; item += gsz) {
        const int b = item >> 4, n = item & 15;
        float cwr[5][2];
#pragma unroll
        for (int k = 0; k < 5; ++k)
#pragma unroll
            for (int e = 0; e < 2; ++e) cwr[k][e] = k < 4 ? a->conv_w[((size_t)j * 4 + k) * DR + n * RBK + 2 * p + e] : a->conv_b[(size_t)j * DR + n * RBK + 2 * p + e];
        __syncthreads();
        for (int i = tid; i < 64 * 10; i += 512) { const int t = i / 10, q = i % 10; *(LAS unsigned*)(xrb + t * 208 + 168 + q * 4) = 0u; }
        for (int dir = 0; dir < 2; ++dir) {
            __syncthreads();
            { const u32x4* img = (const u32x4*)(a->ws + WS_WG + (((size_t)j * 2 + dir) * 16 + n) * WG_IMG);
              for (int i = tid; i < (int)(WG_IMG / 16); i += 512) *(LAS u32x4*)(wg + i * 16) = img[i]; }
            float ba[3], bi[3], cn1[3];
#pragma unroll
            for (int q = 0; q < 3; ++q) { const int ch = 16 * (3 * half + q) + fr; const bool ok = ch < RBK; const size_t o = ((size_t)j * 2 + dir) * DR + n * RBK + (ok ? ch : 0);
                ba[q] = -L2E * a->b_a[o]; bi[q] = -L2E * a->b_i[o]; const float lm = a->lam[o]; const float cneg = -8.f * log1pf(__expf(-lm)); cn1[q] = cneg * L2E; }
            float hcar = 0.f;
            __syncthreads();
            bf16x8 wfa[3][3], wfi0[3];
#pragma unroll
            for (int q = 0; q < 3; ++q)
#pragma unroll
                for (int ks = 0; ks < 3; ++ks) { const int nt = 3 * half + q;
                    wfa[q][ks] = *(const LAS bf16x8*)(wg + (16 * nt + fr) * 208 + ks * 64 + fq * 16);
                    if (q == 0) wfi0[ks] = *(const LAS bf16x8*)(wg + (96 + 16 * nt + fr) * 208 + ks * 64 + fq * 16); }
            unsigned px[9], phf[6], pgt[6];
            auto chunk_info = [&](int ci, int& tl0, int& Tseq, size_t& rowbase) {
                const int cc = dir == 0 ? ci : (ci < 4 ? 3 - ci : 39 - ci);
                if (cc < 4) { tl0 = cc * 64; Tseq = CTXL; rowbase = (size_t)NLAT + (size_t)b * CTXL; } else { tl0 = (cc - 4) * 64; Tseq = SEQL; rowbase = (size_t)b * SEQL; }
            };
            auto issue_x = [&](int ci) {
                int tl0, Tseq; size_t rowbase; chunk_info(ci, tl0, Tseq, rowbase);
                if (tl0 >= 64 && tl0 + 128 <= Tseq) {
                    if (cthr) { const bf16_t* bp = u + (rowbase + tl0 - 2 + tg * 6) * UW + XOFF + n * RBK + 2 * p;
#pragma unroll
                        for (int r = 0; r < 9; ++r) px[r] = *(const unsigned*)(bp + (size_t)r * UW); }
                } else {
#pragma unroll
                    for (int r = 0; r < 9; ++r) { const int t = tl0 - 2 + tg * 6 + r; px[r] = 0u;
                        if (cthr && t >= 0 && t < Tseq) px[r] = *(const unsigned*)(u + (rowbase + t) * UW + XOFF + n * RBK + 2 * p); } }
            };
            auto issue_hg = [&](int ci) {
                int tl0, Tseq; size_t rowbase; chunk_info(ci, tl0, Tseq, rowbase);
                if (cthr) {
#pragma unroll
                    for (int i = 0; i < 6; ++i) { const int tt = min(tg * 6 + i, 63); const size_t row = rowbase + tl0 + tt;
                        phf[i] = *(const unsigned*)(hf + row * DR + n * RBK + 2 * p); pgt[i] = *(const unsigned*)(u + row * UW + n * RBK + 2 * p); } }
            };
            auto conv_store = [&]() {
                if (cthr) {
#pragma unroll
                    for (int i = 0; i < 6; ++i) { const int tt = tg * 6 + i; float o0 = cwr[4][0], o1 = cwr[4][1];
#pragma unroll
                        for (int k = 0; k < 4; ++k) { o0 += cwr[k][0] * bf_lo(px[i + k]); o1 += cwr[k][1] * bf_hi(px[i + k]); }
                        *(LAS unsigned*)(xrb + tt * 208 + p * 4) = cvt_pk_bf16(o0, o1);
                        *(LAS f32x2*)(sx + tt * SBS + 2 * p) = (f32x2){o0, o1}; } }
            };
            issue_x(0);
            conv_store();
            issue_x(1);
            for (int ci = 0; ci < 36; ++ci) {
                int tl0, Tseq; size_t rowbase; chunk_info(ci, tl0, Tseq, rowbase);
                if (dir == 1 && store_v) issue_hg(ci);
                __syncthreads();
                float areg[3][4], breg[3][4];
                { bf16x8 af[3];
#pragma unroll
                  for (int ks = 0; ks < 3; ++ks) af[ks] = *(const LAS bf16x8*)(xrb + (16 * mt + fr) * 208 + ks * 64 + fq * 16);
#pragma unroll
                  for (int q = 0; q < 3; ++q) { const int nt = 3 * half + q;
                      f32x4 za = (f32x4){0.f, 0.f, 0.f, 0.f}, zi = (f32x4){0.f, 0.f, 0.f, 0.f};
#pragma unroll
                      for (int ks = 0; ks < 3; ++ks) { const bf16x8 bfi = (q == 0) ? wfi0[ks] : *(const LAS bf16x8*)(wg + (96 + 16 * nt + fr) * 208 + ks * 64 + fq * 16);
                          za = __builtin_amdgcn_mfma_f32_16x16x32_bf16(af[ks], wfa[q][ks], za, 0, 0, 0); zi = __builtin_amdgcn_mfma_f32_16x16x32_bf16(af[ks], bfi, zi, 0, 0, 0); }
                      const int ch = 16 * nt + fr;
#pragma unroll
                      for (int jj = 0; jj < 4; ++jj) { areg[q][jj] = 0.f; breg[q][jj] = 0.f; }
                      {
#pragma unroll
                          for (int jp = 0; jp < 2; ++jp) { const int t = 16 * mt + 4 * fq + 2 * jp;
                              f32x2 ea, ei; ea.x = __builtin_amdgcn_exp2f(za[2 * jp] + ba[q]); ea.y = __builtin_amdgcn_exp2f(za[2 * jp + 1] + ba[q]);
                              ei.x = __builtin_amdgcn_exp2f(zi[2 * jp] + bi[q]); ei.y = __builtin_amdgcn_exp2f(zi[2 * jp + 1] + bi[q]);
                              ea = ea + 1.f; ei = ei + 1.f;
                              f32x2 r, ig; r.x = __builtin_amdgcn_rcpf(ea.x); r.y = __builtin_amdgcn_rcpf(ea.y); ig.x = __builtin_amdgcn_rcpf(ei.x); ig.y = __builtin_amdgcn_rcpf(ei.y);
                              const f32x2 l2 = r * cn1[q];
                              f32x2 av; av.x = __builtin_amdgcn_exp2f(l2.x); av.y = __builtin_amdgcn_exp2f(l2.y);
                              const f32x2 om = 1.f - av * av;
                              f32x2 sq; sq.x = __builtin_amdgcn_sqrtf(fmaxf(om.x, 0.f)); sq.y = __builtin_amdgcn_sqrtf(fmaxf(om.y, 0.f));
                              f32x2 xv; xv.x = sx[t * SBS + ch]; xv.y = sx[(t + 1) * SBS + ch];
                              const f32x2 bb = sq * ig * xv;
                              areg[q][2 * jp] = av.x; areg[q][2 * jp + 1] = av.y; breg[q][2 * jp] = bb.x; breg[q][2 * jp + 1] = bb.y; }
                          float A, B;
                          if (dir == 0) { A = areg[q][0]; B = breg[q][0];
#pragma unroll
                              for (int jj = 1; jj < 4; ++jj) { B = B * areg[q][jj] + breg[q][jj]; A *= areg[q][jj]; } }
                          else { A = areg[q][3]; B = breg[q][3];
#pragma unroll
                              for (int jj = 2; jj >= 0; --jj) { B = B * areg[q][jj] + breg[q][jj]; A *= areg[q][jj]; } }
                          const int seg = 4 * mt + fq;
                          sa[seg * SAS + ch] = A; sa[16 * SAS + seg * SAS + ch] = B; }
                      __builtin_amdgcn_sched_barrier(0); } }
                __syncthreads();
                if (tid < RBK) {
                    float h = hcar; float Av[8], Bv[8];
#pragma unroll
                    for (int hh = 0; hh < 2; ++hh) { const int q0 = (dir == 0 ? hh : 1 - hh) * 8;
#pragma unroll
                        for (int q = 0; q < 8; ++q) { Av[q] = sa[(q0 + q) * SAS + tid]; Bv[q] = sa[16 * SAS + (q0 + q) * SAS + tid]; }
                        if (dir == 0) {
#pragma unroll
                            for (int q = 0; q < 8; ++q) { const float hin = h; h = Av[q] * h + Bv[q]; Bv[q] = hin; }
                        } else {
#pragma unroll
                            for (int q = 7; q >= 0; --q) { const float hin = h; h = Av[q] * h + Bv[q]; Bv[q] = hin; }
                        }
#pragma unroll
                        for (int q = 0; q < 8; ++q) sa[16 * SAS + (q0 + q) * SAS + tid] = Bv[q]; }
                    hcar = h;
                }
                if (ci + 1 < 36) { conv_store(); if (ci + 2 < 36) issue_x(ci + 2); }
                __syncthreads();
#pragma unroll
                for (int q = 0; q < 3; ++q) { const int ch = 16 * (3 * half + q) + fr;
                    { const int seg = 4 * mt + fq, t0 = 16 * mt + 4 * fq; float h = sa[16 * SAS + seg * SAS + ch];
                        if (dir == 0) {
#pragma unroll
                            for (int jj = 0; jj < 4; ++jj) { h = areg[q][jj] * h + breg[q][jj]; sb[(t0 + jj) * SBS + ch] = h; }
                        } else {
#pragma unroll
                            for (int jj = 3; jj >= 0; --jj) { h = areg[q][jj] * h + breg[q][jj]; sb[(t0 + jj) * SBS + ch] = h; }
                        } } }
                __syncthreads();
                if (cthr) {
                    if (dir == 0) {
#pragma unroll
                        for (int i = 0; i < 6; ++i) { const int tt = min(tg * 6 + i, 63); const f32x2 hv = *(const LAS f32x2*)(sb + tt * SBS + 2 * p);
                            *(unsigned*)(hf + (rowbase + tl0 + tt) * DR + n * RBK + 2 * p) = cvt_pk_bf16(hv.x, hv.y); }
                    } else if (store_v) {
#pragma unroll
                        for (int i = 0; i < 6; ++i) { const int tt = min(tg * 6 + i, 63); const f32x2 hv = *(const LAS f32x2*)(sb + tt * SBS + 2 * p);
                            const float v0 = (bf_lo(phf[i]) + hv.x) * bf_lo(pgt[i]), v1 = (bf_hi(phf[i]) + hv.y) * bf_hi(pgt[i]);
                            *(unsigned*)(u + (rowbase + tl0 + tt) * UW + n * RBK + 2 * p) = cvt_pk_bf16(v0, v1); }
                    }
                }
            }
        }
    }
}

extern "C" __global__ void __launch_bounds__(512) fwd_megakernel(Args a_unused) {
    extern __shared__ __attribute__((aligned(16))) unsigned char shm[];
    LAS unsigned char* lds = (LAS unsigned char*)shm;
    cg::grid_group grid = cg::this_grid();
    (void)a_unused;
    { ArgsP a0 = kargs(); unsigned* bar0 = (unsigned*)(a0->ws + WS_BAR);
      if (blockIdx.x == 0) for (int i = threadIdx.x; i < XCD_BAR_WORDS; i += 512) bar0[i] = 0u;
      if (threadIdx.x < 4) ((volatile LAS unsigned*)(lds + STAGE_BYTES))[threadIdx.x] = 0u; }
    prep_phase(lds, kargs());
    grid.sync();
    { ArgsP a0 = kargs(); unsigned* bar0 = (unsigned*)(a0->ws + WS_BAR); if (threadIdx.x == 0) (void)xb_add(&bar0[XB_XCNT(xb_xcc_id())], 1u); }
#define GRID_SYNC() xcd_barrier((unsigned*)(kargs()->ws + WS_BAR), (volatile LAS unsigned*)(lds + STAGE_BYTES))

    for (int op = -1; op < 36; ++op) {
        ArgsP a = kargs();
        bf16_t* xb = (bf16_t*)(a->ws + WS_XB); bf16_t* hbuf = (bf16_t*)(a->ws + WS_HBUF); bf16_t* big = (bf16_t*)(a->ws + WS_BIG);
        float* mod = (float*)(a->ws + WS_MOD);
        const int layer = op < 0 ? 0 : op / 9, step = op < 0 ? -1 : op % 9;
        const bool fourier = !(layer & 1), last = layer == 3; const int jl = layer >> 1;
        const int nMtok = last ? NLAT / BM : NTOK / BM;
        int type = 0; bool sync = true;
        GemmDesc g; g.a_s1 = g.a_s2 = g.b_s1 = g.b_s2 = 0; g.nZ = 1; g.zdiv = 1; g.mode = 0; g.Cb = nullptr; g.c_s1 = g.c_s2 = g.c_spm = 0; g.ldc = 0; g.act = 0; g.bias = nullptr;
        g.xs32_lat = g.xs32_ctx = nullptr; g.xb = nullptr; g.gate = nullptr; g.Cf = nullptr; g.mrows = 0; g.pm_off = 0; g.halfn = 0; g.A = nullptr; g.Bt = nullptr; g.lda = g.ldb = g.K = 0; g.nM = g.nN = 0;
        if (step == -1) {
            type = 1; g.A = (const bf16_t*)(a->ws + WS_AMOD); g.lda = DM; g.Bt = big; g.ldb = DM; g.K = DM; g.nM = 1; g.nN = MODW / BM; g.mode = 2; g.Cf = mod; g.ldc = MODW; g.bias = a->b_mod; g.mrows = 33;
        } else if (step == 0 || step == 6) {
            type = 2;
        } else if (step == 1) {
            type = 1;
            if (fourier) { g.A = (const bf16_t*)(a->ws + WS_FC); g.lda = 256; g.Bt = hbuf; g.ldb = DM; g.K = 256; g.nM = 2; g.nN = 8; g.nZ = 128; g.zdiv = 4; g.b_s1 = SEQL * DM; g.b_s2 = 256;
                g.Cb = big; g.c_s1 = 1024 * 4096; g.c_s2 = 256 * 4096; g.c_spm = 2048; g.ldc = 4096; sync = false; }
            else { g.A = hbuf; g.lda = DM; g.Bt = (const bf16_t*)(a->ws + WS_WINT) + (size_t)jl * UW * DM; g.ldb = DM; g.K = DM; g.nM = NTOK / BM; g.nN = UW / BM; g.Cb = big; g.c_spm = BM * UW; g.ldc = UW; g.act = 2; }
        } else if (step == 2) {
            if (fourier) { type = 1; g.A = (const bf16_t*)(a->ws + WS_FC); g.lda = 256; g.Bt = hbuf + (size_t)NLAT * DM; g.ldb = DM; g.K = 256; g.nM = 2; g.nN = 1; g.nZ = 128; g.zdiv = 4; g.b_s1 = CTXL * DM; g.b_s2 = 256;
                g.Cb = (bf16_t*)(a->ws + WS_BIG + BIG_PQTC); g.c_s1 = 1024 * 512; g.c_s2 = 256 * 512; g.c_spm = 256; g.ldc = 512; }
            else type = 3;
        } else if (step == 3) {
            if (fourier) { type = 1; g.A = (const bf16_t*)(a->ws + WS_FT); g.lda = 4096; g.Bt = big; g.ldb = 4096; g.K = 4096; g.nM = 4; g.nN = 4; g.nZ = 32; g.b_s1 = 1024 * 4096;
                g.Cb = hbuf; g.c_s1 = SEQL * DM; g.c_spm = BM * DM; g.ldc = DM; g.act = 3; sync = false; }
            else sync = false;
        } else if (step == 4) {
            if (fourier) { type = 1; g.A = (const bf16_t*)(a->ws + WS_FTC); g.lda = 512; g.Bt = (const bf16_t*)(a->ws + WS_BIG + BIG_PQTC); g.ldb = 512; g.K = 512; g.nM = 1; g.nN = 4; g.nZ = 32; g.b_s1 = 1024 * 512;
                g.Cb = hbuf + (size_t)NLAT * DM; g.c_s1 = CTXL * DM; g.c_spm = BM * DM; g.ldc = DM; }
            else sync = false;
        } else if (step == 5) {
            type = 1; g.mode = 1; g.nM = NLAT / BM; g.nN = 4; g.gate = mod + layer * 6 * DM + 2 * DM; g.xb = xb; if (layer == 0) { g.xs32_lat = a->x; g.xs32_ctx = a->ctx; }
            if (fourier) { g.A = hbuf; g.lda = DM; g.Bt = (const bf16_t*)(a->ws + WS_WFT) + (size_t)jl * DM * DM; g.ldb = DM; g.K = DM; }
            else { g.A = big; g.lda = UW; g.Bt = (const bf16_t*)(a->ws + WS_WOT) + (size_t)jl * DM * VK; g.ldb = VK; g.K = VK; }
        } else if (step == 7) {
            type = 1; g.A = hbuf; g.lda = DM; g.Bt = (const bf16_t*)(a->ws + WS_W1T) + (size_t)layer * DFF * DM; g.ldb = DM; g.K = DM; g.nM = nMtok; g.nN = DFF / BM; g.Cb = big; g.c_spm = BM * DFF; g.ldc = DFF; g.bias = a->b1 + layer * DFF; g.act = 1;
        } else {
            type = 1; g.mode = 1; g.A = big; g.lda = DFF; g.Bt = (const bf16_t*)(a->ws + WS_W2T) + (size_t)layer * DM * DFF; g.ldb = DFF; g.K = DFF; g.nM = NLAT / BM; g.nN = 4;
            g.gate = mod + layer * 6 * DM + 5 * DM; g.bias = a->b2 + layer * DM; g.xb = xb;
        }
#ifndef NO_GEMM
        if (type == 1) {
#if DUP_UP
            if (step == 7) { gemm_phase(lds, g); GRID_SYNC(); }
#endif
#if DUP_DFT
            if (fourier && step >= 1 && step <= 4) { gemm_phase(lds, g); if (sync) GRID_SYNC(); }
#endif
            gemm_phase(lds, g);
            if ((step == 5 || step == 8) && !last) {
                g.A += (size_t)(NLAT / BM) * BM * g.lda; g.nM = NCTX / BM; g.pm_off = NLAT / BM; g.halfn = 1; gemm_phase(lds, g); }
            if (fourier && step == 3) dft_mid_row(a); }
#endif
        else if (type == 2) {
#if DUP_NORM
            if (step == 0 && layer == 0) normmod_phase(a, a->x, a->ctx, a->norm_g, mod, 0, NTOK, hbuf);
            else if (step == 0) normmod_bf16_phase(a, xb, a->norm_g + (layer * 2 + 0) * DM, mod + layer * 6 * DM, 0, NTOK, hbuf);
            else normmod_bf16_phase(a, xb, a->norm_g + (layer * 2 + 1) * DM, mod + layer * 6 * DM, 3, last ? NLAT : NTOK, hbuf);
            GRID_SYNC();
#endif
            if (step == 0 && layer == 0) normmod_phase(a, a->x, a->ctx, a->norm_g, mod, 0, NTOK, hbuf);
            else if (step == 0) normmod_bf16_phase(a, xb, a->norm_g + (layer * 2 + 0) * DM, mod + layer * 6 * DM, 0, NTOK, hbuf);
            else normmod_bf16_phase(a, xb, a->norm_g + (layer * 2 + 1) * DM, mod + layer * 6 * DM, 3, last ? NLAT : NTOK, hbuf);
        }
#ifndef NO_SCAN
        else if (type == 3) {
#if DUP_SCAN
            scan_phase(lds, a, jl, false); GRID_SYNC();
#endif
            scan_phase(lds, a, jl, true); }
#endif
        if (sync) GRID_SYNC();
#if DUP_SYNC
        if (sync) GRID_SYNC();
#endif
    }
    final_phase(kargs());
}

extern "C" void kernel_launch(void* const* d_in, const int* in_sizes, int n_in, void* d_out, int out_size, void* d_ws, size_t ws_size, hipStream_t stream) {
    static int grid = 0;
    if (!grid) {
        if (n_in != 22 || out_size != NLAT * DM || ws_size < WS_END) { fprintf(stderr, "kernel_launch: unexpected shapes (n_in %d out %d ws %zu need %zu)\n", n_in, out_size, ws_size, (size_t)WS_END); grid = -1; return; }
        int dev = 0, cus = 0, per_cu = 0;
        (void)hipGetDevice(&dev);
        (void)hipDeviceGetAttribute(&cus, hipDeviceAttributeMultiprocessorCount, dev);
        (void)hipFuncSetAttribute((const void*)fwd_megakernel, hipFuncAttributeMaxDynamicSharedMemorySize, LDS_BYTES);
        (void)hipOccupancyMaxActiveBlocksPerMultiprocessor(&per_cu, (const void*)fwd_megakernel, 512, LDS_BYTES);
        if (per_cu < 1) per_cu = 1;
        grid = cus * per_cu;
    }
    if (grid < 0) return;
    Args a{};
    const float** ap = (const float**)&a;
    for (int i = 0; i < 22; ++i) ap[i] = (const float*)d_in[i];
    a.out = (float*)d_out; a.ws = (unsigned char*)d_ws;
    void* args[] = {&a};
    hipError_t e = hipLaunchCooperativeKernel((const void*)fwd_megakernel, dim3(grid), dim3(512), args, LDS_BYTES, stream);
    if (e != hipSuccess) fprintf(stderr, "cooperative launch failed: %s (grid %d)\n", hipGetErrorString(e), grid);
}
```

```cpp
#include <hip/hip_runtime.h>
#include <hip/hip_cooperative_groups.h>
#include <cstdio>
namespace cg = cooperative_groups;
#ifndef DUP_PREP
#define DUP_PREP 0
#endif
#ifndef DUP_SYNC
#define DUP_SYNC 0
#endif
#ifndef DUP_SCAN
#define DUP_SCAN 0
#endif
#ifndef DUP_NORM
#define DUP_NORM 0
#endif
#ifndef DUP_UP
#define DUP_UP 0
#endif
#ifndef DUP_DFT
#define DUP_DFT 0
#endif

#define LAS __attribute__((address_space(3)))
#define CAS __attribute__((address_space(4)))
typedef unsigned short bf16_t;
typedef short bf16x8 __attribute__((ext_vector_type(8)));
typedef float f32x4 __attribute__((ext_vector_type(4)));
typedef float f32x2 __attribute__((ext_vector_type(2)));
typedef unsigned u32x4 __attribute__((ext_vector_type(4)));
typedef unsigned u32x2 __attribute__((ext_vector_type(2)));

constexpr int DM = 1024, NB = 32, SEQL = 2048, CTXL = 256, NLAT = NB * SEQL, NCTX = NB * CTXL, NTOK = NLAT + NCTX;
constexpr int DFF = 4096, DR = 1344, RBK = 84, UW = 2816, VK = 1408, XOFF = 1408, MODW = 24576;
constexpr int BM = 256, BK = 64, HALF = 128, HTB = HALF * BK * 2, STAGE_BYTES = 8 * HTB, NXCD = 8, WGM = 8;
constexpr int LDS_BYTES = STAGE_BYTES + 16;

constexpr size_t WS_XB = 0;
constexpr size_t WS_HBUF = WS_XB + (size_t)NTOK * DM * 2;
constexpr size_t WS_BIG = WS_HBUF + (size_t)NTOK * DR * 2;
constexpr size_t WS_W1T = WS_BIG + (size_t)NTOK * DFF * 2;
constexpr size_t WS_W2T = WS_W1T + (size_t)4 * DFF * DM * 2;
constexpr size_t WS_WFT = WS_W2T + (size_t)4 * DFF * DM * 2;
constexpr size_t WS_WINT = WS_WFT + (size_t)2 * DM * DM * 2;
constexpr size_t WS_WOT = WS_WINT + (size_t)2 * UW * DM * 2;
constexpr size_t WS_FT = WS_WOT + (size_t)2 * DM * VK * 2;
constexpr size_t WS_FTC = WS_FT + (size_t)SEQL * 2 * SEQL * 2;
constexpr size_t WS_FC = WS_FTC + (size_t)CTXL * 2 * CTXL * 2;
constexpr size_t WS_AMOD = WS_FC + (size_t)512 * 256 * 2;
constexpr size_t WS_MOD = WS_AMOD + (size_t)256 * DM * 2;
constexpr size_t WS_BAR = WS_MOD + (size_t)33 * MODW * 4;
constexpr size_t WS_WG = WS_BAR + 16384;
constexpr size_t WG_IMG = 192 * 208;
constexpr size_t WS_END = WS_WG + (size_t)2 * 2 * 16 * WG_IMG;
static_assert(WS_END <= ((size_t)1 << 30), "workspace");
constexpr size_t BIG_PQTC = (size_t)NB * 1024 * 4096 * 2;

struct Args {
    const float *x, *c, *ctx, *c_ctx, *w_mod, *b_mod, *norm_g, *w_fourier, *w_rnn_in, *conv_w, *conv_b, *w_a, *b_a, *w_i, *b_i, *lam, *w_rnn_out, *w1, *b1, *w2, *b2, *final_g;
    float* out; unsigned char* ws;
};
typedef const CAS Args* ArgsP;
__device__ __forceinline__ ArgsP kargs() { ArgsP p = (ArgsP)__builtin_amdgcn_kernarg_segment_ptr(); asm volatile("" : "+s"(p)); return p; }

__device__ __forceinline__ unsigned cvt_pk_bf16(float lo, float hi) { unsigned r; asm volatile("v_cvt_pk_bf16_f32 %0, %1, %2" : "=v"(r) : "v"(lo), "v"(hi)); return r; }
__device__ __forceinline__ float bf_lo(unsigned w) { return __uint_as_float(w << 16); }
__device__ __forceinline__ float bf_hi(unsigned w) { return __uint_as_float(w & 0xffff0000u); }
__device__ __forceinline__ int otid() { int t = threadIdx.x; asm volatile("" : "+v"(t)); return t; }
__device__ __forceinline__ int obid() { int t = blockIdx.x; asm volatile("" : "+s"(t)); return t; }
__device__ __forceinline__ int ogrid() { int t = gridDim.x; asm volatile("" : "+s"(t)); return t; }
__device__ __forceinline__ float wave_sum(float v) {
#pragma unroll
    for (int o = 1; o < 64; o <<= 1) v += __shfl_xor(v, o);
    return v;
}


#define XB_TMO      128
#define XB_XCNT(j)  (256  + 64 * (j))
#define XB_XSUB(j)  (1280 + 64 * (j))
#define XB_XGEN(j)  (2304 + 64 * (j))
#define XB_TOP      3328
#define XB_TOPGEN   3392
#define XCD_BAR_WORDS 3456
#define XB_SPIN_CAP (1u << 20)
__device__ __forceinline__ unsigned xb_ld(unsigned* p)              { return __hip_atomic_load(p, __ATOMIC_RELAXED, __HIP_MEMORY_SCOPE_AGENT); }
__device__ __forceinline__ unsigned xb_add(unsigned* p, unsigned v) { return __hip_atomic_fetch_add(p, v, __ATOMIC_RELAXED, __HIP_MEMORY_SCOPE_AGENT); }
__device__ __forceinline__ unsigned xb_xcc_id() { return (unsigned)__builtin_amdgcn_s_getreg((3 << 11) | 20) & 0xFu; }
#define XB_SPIN(cond, bar) do { unsigned _sp = 0; while (cond) { __builtin_amdgcn_s_sleep(1); \
    if ((++_sp & 255u) == 0u) { if (xb_ld(&(bar)[XB_TMO])) break; if (_sp > XB_SPIN_CAP) { atomicAdd(&(bar)[XB_TMO], 1u); break; } } } } while (0)
__device__ __forceinline__ void xcd_barrier_complete(unsigned* bar, unsigned x, unsigned& nloc, unsigned& nx) {
    const unsigned G = gridDim.x;
    unsigned sum, cnt, mine, sp = 0u;
    for (;;) {
        sum = 0u; cnt = 0u; mine = 0u;
#pragma unroll
        for (unsigned j = 0; j < 16; ++j) { const unsigned c = xb_ld(&bar[XB_XCNT(j)]); sum += c; cnt += (c > 0u) ? 1u : 0u; mine = (j == x) ? c : mine; }
        if (sum == G) break;
        __builtin_amdgcn_s_sleep(1);
        if ((++sp & 255u) == 0u) { if (xb_ld(&bar[XB_TMO])) break; if (sp > XB_SPIN_CAP) { atomicAdd(&bar[XB_TMO], 1u); break; } }
    }
    nloc = mine > 0u ? mine : 1u; nx = cnt > 0u ? cnt : 1u;
}
__device__ __forceinline__ void xcd_barrier(unsigned* bar, volatile LAS unsigned* st) {
    asm volatile("s_waitcnt vmcnt(0)" ::: "memory");
    __syncthreads();
    if (threadIdx.x == 0) {
        const unsigned x = xb_xcc_id();
        __builtin_amdgcn_s_waitcnt(0);
        unsigned nloc = st[0], nx = st[1];
        if (nloc == 0u) { xcd_barrier_complete(bar, x, nloc, nx); st[0] = nloc; st[1] = nx; }
        const unsigned old = xb_add(&bar[XB_XSUB(x)], 1u);
        const unsigned gen = old / nloc;
        if (old + 1u == (gen + 1u) * nloc) {
            __builtin_amdgcn_fence(__ATOMIC_RELEASE, "agent");
            asm volatile("s_waitcnt vmcnt(0)" ::: "memory");
            const unsigned og = xb_add(&bar[XB_TOP], 1u);
            const unsigned tg = og / nx;
            if (og + 1u == (tg + 1u) * nx) xb_add(&bar[XB_TOPGEN], 1u);
            else XB_SPIN(xb_ld(&bar[XB_TOPGEN]) == tg, bar);
            __builtin_amdgcn_fence(__ATOMIC_ACQUIRE, "agent");
            xb_add(&bar[XB_XGEN(x)], 1u);
            asm volatile("s_waitcnt vmcnt(0)" ::: "memory");
        } else {
            XB_SPIN(xb_ld(&bar[XB_XGEN(x)]) == gen, bar);
            __builtin_amdgcn_fence(__ATOMIC_ACQUIRE, "agent");
            asm volatile("s_waitcnt vmcnt(0)" ::: "memory");
        }
    }
    __syncthreads();
}

__device__ __forceinline__ int lds_byte(int r, int c) { const int st = (r >> 4) * 2 + (c >> 5), rr = r & 15, cc = c & 31, ob = rr * 64 + cc * 2; return st * 1024 + (ob ^ (((ob >> 9) & 1) << 5)); }
__device__ __forceinline__ void stage_rc(int b, int& R, int& C) { const int st = b / 1024, sb = b % 1024, swz = sb ^ (((sb >> 9) & 1) << 5); R = (st >> 1) * 16 + swz / 64; C = (st & 1) * 32 + (swz % 64) / 2; }
__device__ __forceinline__ int perm32(int rho) { const int n = rho >> 4, i = rho & 15; return 8 * (i >> 2) + 4 * n + (i & 3); }

struct Unit { int pm, pn, z, hs; };
struct GemmDesc {
    const bf16_t* A; const bf16_t* Bt;
    int a_s1, a_s2, b_s1, b_s2;
    int lda, ldb, K, nM, nN, nZ, zdiv;
    int mode;
    bf16_t* Cb; int c_s1, c_s2, c_spm; int ldc; int act;
    const float* bias;
    const float *xs32_lat, *xs32_ctx; bf16_t* xb; const float* gate;
    float* Cf; int mrows; int pm_off, halfn;
};

__device__ __forceinline__ bool unit_at(const GemmDesc& g, int i, int G, int c, Unit& u) {
    const int nNe = g.halfn ? 2 * g.nN : g.nN; const int per = g.nM * nNe, nwg = per * g.nZ;
    const long L = (long)i * G + c; if (L >= nwg) return false;
    int wgid = (int)L; { const int q = nwg / NXCD, r = nwg % NXCD, xcd = wgid % NXCD, off = wgid / NXCD; wgid = (xcd < r ? xcd * (q + 1) : r * (q + 1) + (xcd - r) * q) + off; }
    u.z = wgid / per; const int w = wgid % per;
    const int nig = WGM * nNe, gid = w / nig, fm = gid * WGM, gsz = (g.nM - fm) < WGM ? (g.nM - fm) : WGM;
    u.pm = fm + ((w % nig) % gsz); const int pne = (w % nig) / gsz; u.hs = g.halfn ? (pne & 1) : 0; u.pn = g.halfn ? (pne >> 1) : pne; return true;
}

__device__ __forceinline__ void epilogue(const GemmDesc& g, const f32x4 (&acc)[2][2][4][2], const Unit& u) {
    const int tid_e = otid(), wid_e = tid_e >> 6, lane_e = tid_e & 63, wr = wid_e >> 2, wc = wid_e & 3, fr = lane_e & 15, fq = lane_e >> 4;
    if (g.mode == 0) {
        bf16_t* base = g.Cb + (long)((u.z / g.zdiv) * g.c_s1 + (u.z % g.zdiv) * g.c_s2 + u.pm * g.c_spm + u.pn * BM);
        const int rl0 = wr * 64 + fr, cl0 = wc * 64 + 8 * fq;
        f32x4 bv[2][2];
#pragma unroll
        for (int bj = 0; bj < 2; ++bj)
#pragma unroll
            for (int n = 0; n < 2; ++n) bv[bj][n] = g.bias ? *(const f32x4*)(g.bias + u.pn * BM + cl0 + bj * 32 + 4 * n) : (f32x4){0.f, 0.f, 0.f, 0.f};
#pragma unroll
        for (int ai = 0; ai < 2; ++ai)
#pragma unroll
            for (int m = 0; m < 4; ++m) { bf16_t* rowp = base + (long)(rl0 + ai * HALF + m * 16) * g.ldc + cl0;
#pragma unroll
                for (int bj = 0; bj < 2; ++bj) { f32x4 v0 = acc[ai][bj][m][0] + bv[bj][0], v1 = acc[ai][bj][m][1] + bv[bj][1];
                    if (g.act == 1) {
#pragma unroll
                        for (int j = 0; j < 4; ++j) { float t0 = fmaxf(v0[j], 0.f), t1 = fmaxf(v1[j], 0.f); v0[j] = t0 * t0; v1[j] = t1 * t1; } }
                    else if (g.act == 2 && (u.pn * BM + cl0 + bj * 32) < XOFF) {
#pragma unroll
                        for (int j = 0; j < 4; ++j) { const float a0 = v0[j], a1 = v1[j];
                            v0[j] = a0 * __builtin_amdgcn_rcpf(1.f + __builtin_amdgcn_exp2f(a0 * (-2.3022082f + -0.10294324f * a0 * a0)));
                            v1[j] = a1 * __builtin_amdgcn_rcpf(1.f + __builtin_amdgcn_exp2f(a1 * (-2.3022082f + -0.10294324f * a1 * a1))); } }
                    u32x4 w; w.x = cvt_pk_bf16(v0[0], v0[1]); w.y = cvt_pk_bf16(v0[2], v0[3]); w.z = cvt_pk_bf16(v1[0], v1[1]); w.w = cvt_pk_bf16(v1[2], v1[3]);
                    *(u32x4*)(rowp + bj * 32) = w;
                    if (g.act == 3) {
                        const int k = u.pm * BM + rl0 + ai * HALF + m * 16;
                        if (k >= 1) { const int l0 = cl0 + bj * 32;
                            bf16_t* mrow = g.Cb + (long)(u.z * g.c_s1 + (SEQL - k) * g.ldc + u.pn * BM);
                            mrow[(256 - l0) & 255] = (bf16_t)(w.x & 0xffffu);
                            *(unsigned*)(mrow + 254 - l0) = cvt_pk_bf16(v0[2], v0[1]);
                            *(unsigned*)(mrow + 252 - l0) = cvt_pk_bf16(v1[0], v0[3]);
                            *(unsigned*)(mrow + 250 - l0) = cvt_pk_bf16(v1[2], v1[1]);
                            mrow[249 - l0] = (bf16_t)(w.w >> 16); } } }
                __builtin_amdgcn_sched_barrier(0); }
    } else if (g.mode == 1) {
        const int R0 = (u.pm + g.pm_off) * BM; const int rl0 = wr * 64 + fr, cl0 = u.pn * BM + wc * 64 + 8 * fq + u.hs * 32;
        const float* gate = g.gate + (size_t)(R0 < NLAT ? (R0 >> 11) : 32) * MODW;
        bf16_t* dst = g.xb + (size_t)R0 * DM;
        const float* src32 = g.xs32_lat ? (R0 < NLAT ? g.xs32_lat + (size_t)R0 * DM : g.xs32_ctx + (size_t)(R0 - NLAT) * DM) : nullptr;
#pragma unroll
        for (int bj = 0; bj < 2; ++bj) {
            if (bj == 1 && g.halfn) break;
            f32x4 gv0 = *(const f32x4*)(gate + cl0 + bj * 32), gv1 = *(const f32x4*)(gate + cl0 + bj * 32 + 4);
            f32x4 gb0 = (f32x4){0.f, 0.f, 0.f, 0.f}, gb1 = (f32x4){0.f, 0.f, 0.f, 0.f};
            if (g.bias) { gb0 = *(const f32x4*)(g.bias + cl0 + bj * 32); gb1 = *(const f32x4*)(g.bias + cl0 + bj * 32 + 4); }
            if (src32) {
                gb0 = gb0 * gv0; gb1 = gb1 * gv1;
#pragma unroll
                for (int ai = 0; ai < 2; ++ai)
#pragma unroll
                    for (int m = 0; m < 4; ++m) { const size_t ro = (size_t)(rl0 + ai * HALF + m * 16) * DM + cl0 + bj * 32;
                        const f32x4 x0 = *(const f32x4*)(src32 + ro), x1 = *(const f32x4*)(src32 + ro + 4);
                        const f32x4 y0 = x0 + (gv0 * acc[ai][bj][m][0] + gb0), y1 = x1 + (gv1 * acc[ai][bj][m][1] + gb1);
                        u32x4 w; w.x = cvt_pk_bf16(y0[0], y0[1]); w.y = cvt_pk_bf16(y0[2], y0[3]); w.z = cvt_pk_bf16(y1[0], y1[1]); w.w = cvt_pk_bf16(y1[2], y1[3]);
                        *(u32x4*)(dst + ro) = w;
                        if (m & 1) __builtin_amdgcn_sched_barrier(0); }
            } else {
#pragma unroll
                for (int ai = 0; ai < 2; ++ai) {
                    u32x4 xw[4];
#pragma unroll
                    for (int m = 0; m < 4; ++m) xw[m] = *(const u32x4*)(dst + (size_t)(rl0 + ai * HALF + m * 16) * DM + cl0 + bj * 32);
                    __builtin_amdgcn_sched_barrier(0);
                    if (ai == 0) { gb0 = gb0 * gv0; gb1 = gb1 * gv1; }
#pragma unroll
                    for (int m = 0; m < 4; ++m) { const size_t ro = (size_t)(rl0 + ai * HALF + m * 16) * DM + cl0 + bj * 32; const u32x4 q = xw[m];
                        const f32x4 x0 = (f32x4){bf_lo(q.x), bf_hi(q.x), bf_lo(q.y), bf_hi(q.y)}, x1 = (f32x4){bf_lo(q.z), bf_hi(q.z), bf_lo(q.w), bf_hi(q.w)};
                        const f32x4 y0 = x0 + (gv0 * acc[ai][bj][m][0] + gb0), y1 = x1 + (gv1 * acc[ai][bj][m][1] + gb1);
                        u32x4 w; w.x = cvt_pk_bf16(y0[0], y0[1]); w.y = cvt_pk_bf16(y0[2], y0[3]); w.z = cvt_pk_bf16(y1[0], y1[1]); w.w = cvt_pk_bf16(y1[2], y1[3]);
                        *(u32x4*)(dst + ro) = w; }
                    __builtin_amdgcn_sched_barrier(0); }
            }
        }
    } else {
        const int R0 = u.pm * BM; const int col0 = u.pn * BM + wc * 32 + 4 * fq; const int rl0 = wr * 64 + fr;
        f32x4 bv[2][2];
#pragma unroll
        for (int bj = 0; bj < 2; ++bj)
#pragma unroll
            for (int n = 0; n < 2; ++n) bv[bj][n] = g.bias ? *(const f32x4*)(g.bias + col0 + bj * HALF + n * 16) : (f32x4){0.f, 0.f, 0.f, 0.f};
#pragma unroll
        for (int ai = 0; ai < 2; ++ai)
#pragma unroll
            for (int m = 0; m < 4; ++m) { const int r = R0 + rl0 + ai * HALF + m * 16;
                if (r < g.mrows) { float* rowp = g.Cf + (size_t)r * g.ldc + col0;
#pragma unroll
                    for (int bj = 0; bj < 2; ++bj)
#pragma unroll
                        for (int n = 0; n < 2; ++n) *(f32x4*)(rowp + bj * HALF + n * 16) = acc[ai][bj][m][n] + bv[bj][n]; } }
    }
}

__device__ __forceinline__ void gemm_phase(LAS unsigned char* lds, const GemmDesc& g) {
    const int tid = otid(), wid = __builtin_amdgcn_readfirstlane(tid >> 6), lane = tid & 63, wr = wid >> 2, wc = wid & 3, fr = lane & 15, fq = lane >> 4;
    const int nt = g.K / BK; const int G = ogrid(), cblk = obid();
    const bool perm = (g.mode != 2); const bool fulln = (g.halfn == 0);
    unsigned voffA[2], voffB[2];
#pragma unroll
    for (int i = 0; i < 2; ++i) { int R, C; stage_rc(tid * 16 + i * 8192, R, C); const int Rb = perm ? (64 * (R >> 5) + perm32(R & 31)) : R;
        voffA[i] = (unsigned)(R * g.lda + C) * 2u; voffB[i] = (unsigned)(Rb * g.ldb + C) * 2u; }
    const size_t kstep = (size_t)(BK * 2);
    const size_t hstepA = (size_t)HALF * g.lda * 2, hstepB = (size_t)(perm ? 32 : HALF) * g.ldb * 2;
    const unsigned ldsw = (unsigned)wid * 1024u;
    const int aoff = lds_byte(wr * 64 + fr, fq * 8), boff = lds_byte(wc * 32 + fr, fq * 8);
#define PG8_SA(b, h) (((b) * 2 + (h)) * HTB)
#define PG8_SB(b, h) ((4 + (b) * 2 + (h)) * HTB)
#define PG8_STAGE(bufoff, gbase, voff) do { _Pragma("unroll") for (int _i = 0; _i < 2; ++_i) \
        __builtin_amdgcn_global_load_lds((const unsigned*)((const char*)(gbase) + (voff)[_i]), (LAS unsigned*)(lds + (bufoff) + ldsw + _i * 8192), 16, 0, 0); } while (0)
#define PG8_LDA(dst, b, h) do { _Pragma("unroll") for (int m = 0; m < 4; ++m) _Pragma("unroll") for (int k = 0; k < 2; ++k) dst[m][k] = *(const LAS bf16x8*)(lds + PG8_SA(b, h) + aoff + m * 2048 + k * 1024); } while (0)
#define PG8_LDB(dst, b, h) do { _Pragma("unroll") for (int n = 0; n < 2; ++n) _Pragma("unroll") for (int k = 0; k < 2; ++k) dst[n][k] = *(const LAS bf16x8*)(lds + PG8_SB(b, h) + boff + n * 2048 + k * 1024); } while (0)
#define PG8_MMA(ai, bj, At, Bt) do { __builtin_amdgcn_s_setprio(1); _Pragma("unroll") for (int m = 0; m < 4; ++m) _Pragma("unroll") for (int n = 0; n < 2; ++n) _Pragma("unroll") for (int k = 0; k < 2; ++k) \
        acc[ai][bj][m][n] = __builtin_amdgcn_mfma_f32_16x16x32_bf16(Bt[n][k], At[m][k], acc[ai][bj][m][n], 0, 0, 0); __builtin_amdgcn_s_setprio(0); } while (0)
#define PG8_WAIT_V(n) asm volatile("s_waitcnt vmcnt(" #n ")" ::: "memory")
#define PG8_WAIT_L(n) asm volatile("s_waitcnt lgkmcnt(" #n ")" ::: "memory")
#define PG8_BAR __builtin_amdgcn_s_barrier()
#define PG8_SCHED __builtin_amdgcn_sched_barrier(0)
    Unit cur, nxt; int ui = 0;
    if (!unit_at(g, 0, G, cblk, cur)) return;
    f32x4 acc[2][2][4][2];
#pragma unroll
    for (int a = 0; a < 2; ++a)
#pragma unroll
        for (int b = 0; b < 2; ++b)
#pragma unroll
            for (int m = 0; m < 4; ++m)
#pragma unroll
                for (int n = 0; n < 2; ++n) acc[a][b][m][n] = (f32x4){0.f, 0.f, 0.f, 0.f};
    bf16x8 At[4][2], B0[2][2], B1[2][2];
    const char* cA = (const char*)(g.A + (long)((cur.z / g.zdiv) * g.a_s1 + (cur.z % g.zdiv) * g.a_s2 + cur.pm * BM * g.lda));
    const char* cB = (const char*)(g.Bt + (long)((cur.z / g.zdiv) * g.b_s1 + (cur.z % g.zdiv) * g.b_s2 + (cur.pn * BM + cur.hs * 32) * g.ldb));
    PG8_STAGE(PG8_SB(0, 0), cB, voffB); PG8_STAGE(PG8_SA(0, 0), cA, voffA); PG8_STAGE(PG8_SB(0, 1), cB + hstepB, voffB); PG8_STAGE(PG8_SA(0, 1), cA + hstepA, voffA);
    if (wr == 1) PG8_BAR;
    PG8_WAIT_V(4); PG8_BAR;
    PG8_STAGE(PG8_SB(1, 0), cB + kstep, voffB); PG8_STAGE(PG8_SA(1, 0), cA + kstep, voffA); PG8_STAGE(PG8_SB(1, 1), cB + hstepB + kstep, voffB);
    PG8_WAIT_V(6); PG8_BAR;
    for (;;) {
        const bool has_next = unit_at(g, ui + 1, G, cblk, nxt);
        const char* nA = has_next ? (const char*)(g.A + (long)((nxt.z / g.zdiv) * g.a_s1 + (nxt.z % g.zdiv) * g.a_s2 + nxt.pm * BM * g.lda)) : cA;
        const char* nB = has_next ? (const char*)(g.Bt + (long)((nxt.z / g.zdiv) * g.b_s1 + (nxt.z % g.zdiv) * g.b_s2 + (nxt.pn * BM + nxt.hs * 32) * g.ldb)) : cB;
        for (int t = 0; t < nt; t += 2) {
            const bool last = (t == nt - 2);
            const char* a1 = cA + (size_t)(t + 1) * kstep;
            const char* a2 = last ? nA : cA + (size_t)(t + 2) * kstep; const char* b2 = last ? nB : cB + (size_t)(t + 2) * kstep;
            const char* a3 = a2 + kstep; const char* b3 = b2 + kstep;
            PG8_LDB(B0, 0, 0); PG8_SCHED; PG8_LDA(At, 0, 0); PG8_STAGE(PG8_SA(1, 1), a1 + hstepA, voffA);
            PG8_WAIT_L(8); PG8_BAR; PG8_WAIT_L(0); PG8_MMA(0, 0, At, B0); PG8_BAR; PG8_SCHED;
            if (fulln) PG8_LDB(B1, 0, 1); PG8_STAGE(PG8_SB(0, 0), b2, voffB);
            PG8_BAR; PG8_WAIT_L(0); if (fulln) PG8_MMA(0, 1, At, B1); PG8_BAR;
            PG8_LDA(At, 0, 1); PG8_STAGE(PG8_SA(0, 0), a2, voffA);
            PG8_BAR; PG8_WAIT_L(0); PG8_MMA(1, 0, At, B0); PG8_BAR; PG8_SCHED;
            PG8_STAGE(PG8_SB(0, 1), b2 + hstepB, voffB);
            PG8_WAIT_V(6); PG8_BAR; if (fulln) PG8_MMA(1, 1, At, B1); PG8_BAR;
            PG8_LDB(B0, 1, 0); PG8_SCHED; PG8_LDA(At, 1, 0); PG8_STAGE(PG8_SA(0, 1), a2 + hstepA, voffA);
            PG8_WAIT_L(8); PG8_BAR; PG8_WAIT_L(0); PG8_MMA(0, 0, At, B0); PG8_BAR; PG8_SCHED;
            if (fulln) PG8_LDB(B1, 1, 1); PG8_STAGE(PG8_SB(1, 0), b3, voffB);
            PG8_BAR; PG8_WAIT_L(0); if (fulln) PG8_MMA(0, 1, At, B1); PG8_BAR;
            PG8_LDA(At, 1, 1); PG8_STAGE(PG8_SA(1, 0), a3, voffA);
            PG8_BAR; PG8_WAIT_L(0); PG8_MMA(1, 0, At, B0); PG8_BAR; PG8_SCHED;
            PG8_STAGE(PG8_SB(1, 1), b3 + hstepB, voffB);
            PG8_WAIT_V(6); PG8_BAR; if (fulln) PG8_MMA(1, 1, At, B1); PG8_BAR;
        }
        epilogue(g, acc, cur);
        if (!has_next) break;
#pragma unroll
        for (int a = 0; a < 2; ++a)
#pragma unroll
            for (int b = 0; b < 2; ++b)
#pragma unroll
                for (int m = 0; m < 4; ++m)
#pragma unroll
                    for (int n = 0; n < 2; ++n) acc[a][b][m][n] = (f32x4){0.f, 0.f, 0.f, 0.f};
        cur = nxt; cA = nA; cB = nB; ++ui;
    }
    PG8_WAIT_V(0);
    if (wr == 0) PG8_BAR;
    PG8_BAR;
#undef PG8_SA
#undef PG8_SB
#undef PG8_STAGE
#undef PG8_LDA
#undef PG8_LDB
#undef PG8_MMA
#undef PG8_WAIT_V
#undef PG8_WAIT_L
#undef PG8_BAR
#undef PG8_SCHED
}

__device__ __forceinline__ void transpose_item(const float* W, int N, bf16_t* WT, int ldk, int row_off, LAS float* scr, int kb, int nb, int lane) {
    const int k0 = 64 * kb, n0 = 32 * nb;
    float tv[32];
#pragma unroll
    for (int i = 0; i < 32; ++i) tv[i] = W[(size_t)(k0 + 2 * i + (lane >> 5)) * N + n0 + (lane & 31)];
#pragma unroll
    for (int i = 0; i < 32; ++i) scr[(2 * i + (lane >> 5)) * 33 + (lane & 31)] = tv[i];
    asm volatile("s_waitcnt lgkmcnt(0)" ::: "memory");
    const int c = lane & 7;
#pragma unroll
    for (int j = 0; j < 4; ++j) { const int n = (lane >> 3) + 8 * j; const LAS float* s = scr + (8 * c) * 33 + n;
        u32x4 o; o.x = cvt_pk_bf16(s[0 * 33], s[1 * 33]); o.y = cvt_pk_bf16(s[2 * 33], s[3 * 33]); o.z = cvt_pk_bf16(s[4 * 33], s[5 * 33]); o.w = cvt_pk_bf16(s[6 * 33], s[7 * 33]);
        *(u32x4*)(WT + (size_t)(row_off + n0 + n) * ldk + k0 + 8 * c) = o; }
    asm volatile("s_waitcnt lgkmcnt(0)" ::: "memory");
}

__device__ __forceinline__ float silu_f(float v) { return v / (1.f + __expf(-v)); }

__device__ __forceinline__ void prep_phase(LAS unsigned char* lds, ArgsP a) {
    const int tid = otid(), wave = tid >> 6, lane = tid & 63; const int bid = obid(), gsz = ogrid();
    LAS float* scr = (LAS float*)(lds + wave * 16384);
    bf16_t* w1t = (bf16_t*)(a->ws + WS_W1T); bf16_t* w2t = (bf16_t*)(a->ws + WS_W2T); bf16_t* wft = (bf16_t*)(a->ws + WS_WFT);
    bf16_t* wint = (bf16_t*)(a->ws + WS_WINT); bf16_t* wot = (bf16_t*)(a->ws + WS_WOT); bf16_t* wmodt = (bf16_t*)(a->ws + WS_BIG);
    const int gw = bid * 8 + wave, NGW = gsz * 8;
    constexpr int I_W1 = 2048, I_W2 = 2048, I_WF = 512, I_WIN = 1344, I_WOUT = 672, I_WMOD = 3072;
    constexpr int NITEMS = 4 * I_W1 + 4 * I_W2 + 2 * I_WF + 2 * I_WIN + 2 * I_WOUT + 4 * I_WMOD;
    for (int it = gw; it < NITEMS; it += NGW) {
        int r = it;
        if (r < 4 * I_W1) { const int l = r / I_W1, q = r % I_W1; transpose_item(a->w1 + (size_t)l * DM * DFF, DFF, w1t + (size_t)l * DFF * DM, DM, 0, scr, q / 128, q % 128, lane); continue; } r -= 4 * I_W1;
        if (r < 4 * I_W2) { const int l = r / I_W2, q = r % I_W2; transpose_item(a->w2 + (size_t)l * DFF * DM, DM, w2t + (size_t)l * DM * DFF, DFF, 0, scr, q / 32, q % 32, lane); continue; } r -= 4 * I_W2;
        if (r < 2 * I_WF) { const int l = r / I_WF, q = r % I_WF; transpose_item(a->w_fourier + (size_t)l * DM * DM, DM, wft + (size_t)l * DM * DM, DM, 0, scr, q / 32, q % 32, lane); continue; } r -= 2 * I_WF;
        if (r < 2 * I_WIN) { const int l = r / I_WIN, q = r % I_WIN; const int nb = q % 84;
            transpose_item(a->w_rnn_in + (size_t)l * DM * 2 * DR, 2 * DR, wint + (size_t)l * UW * DM, DM, nb >= 42 ? 64 : 0, scr, q / 84, nb, lane); continue; } r -= 2 * I_WIN;
        if (r < 2 * I_WOUT) { const int l = r / I_WOUT, q = r % I_WOUT; transpose_item(a->w_rnn_out + (size_t)l * DR * DM, DM, wot + (size_t)l * DM * VK, VK, 0, scr, q / 32, q % 32, lane); continue; } r -= 2 * I_WOUT;
        { const int l = r / I_WMOD, q = r % I_WMOD; transpose_item(a->w_mod + (size_t)l * DM * 6 * DM, 6 * DM, wmodt + (size_t)l * 6 * DM * DM, DM, 0, scr, q / 192, q % 192, lane); }
    }
    const size_t gt = (size_t)bid * 512 + tid, GT = (size_t)gsz * 512;
    unsigned* ft = (unsigned*)(a->ws + WS_FT);
    for (size_t i = gt; i < (size_t)SEQL * SEQL * 2 / 2; i += GT) {
        const int k = (int)(i / 2048), col = (int)(i % 2048) * 2, cs = col >> 11, t = col & 2047; float v[2];
#pragma unroll
        for (int e = 0; e < 2; ++e) { const float ang = (float)((k * (t + e)) & 2047) * (1.f / 1024.f); v[e] = (cs == 0 ? cospif(ang) : -sinpif(ang)) * 0.02209708691207961f; }
        ft[i] = cvt_pk_bf16(v[0], v[1]);
    }
    unsigned* ftc = (unsigned*)(a->ws + WS_FTC);
    for (size_t i = gt; i < (size_t)CTXL * CTXL * 2 / 2; i += GT) {
        const int k = (int)(i / 256), col = (int)(i % 256) * 2, cs = col >> 8, t = col & 255; float v[2];
#pragma unroll
        for (int e = 0; e < 2; ++e) { const float ang = (float)((k * (t + e)) & 255) * (1.f / 128.f); v[e] = (cs == 0 ? cospif(ang) : -sinpif(ang)) * 0.0625f; }
        ftc[i] = cvt_pk_bf16(v[0], v[1]);
    }
    unsigned* fc = (unsigned*)(a->ws + WS_FC);
    for (size_t i = gt; i < (size_t)512 * 256 / 2; i += GT) {
        const int m = (int)(i / 128), col = (int)(i % 128) * 2, cs = m >> 8, l = m & 255; float v[2];
#pragma unroll
        for (int e = 0; e < 2; ++e) { const float ang = (float)((l * (col + e)) & 255) * (1.f / 128.f); v[e] = (cs == 0 ? cospif(ang) : sinpif(ang)) * 0.0625f; }
        fc[i] = cvt_pk_bf16(v[0], v[1]);
    }
    unsigned* amod = (unsigned*)(a->ws + WS_AMOD);
    for (size_t i = gt; i < (size_t)256 * DM / 2; i += GT) {
        const int row = (int)(i / 512), col = (int)(i % 512) * 2; float v0 = 0.f, v1 = 0.f;
        if (row < 32) { v0 = silu_f(a->c[row * DM + col]); v1 = silu_f(a->c[row * DM + col + 1]); }
        else if (row == 32) { v0 = silu_f(a->c_ctx[col]); v1 = silu_f(a->c_ctx[col + 1]); }
        amod[i] = cvt_pk_bf16(v0, v1);
    }
    { unsigned* wgi = (unsigned*)(a->ws + WS_WG);
      for (size_t i = gt; i < (size_t)2 * 2 * 16 * 192 * 52; i += GT) {
          const int kp = (int)(i % 52), row = (int)((i / 52) % 192), blk = (int)(i / (52 * 192));
          const int part = row / 96, jo = row % 96, k0 = kp * 2; float v0 = 0.f, v1 = 0.f;
          if (jo < RBK) { const float* w = (part ? a->w_i : a->w_a) + (size_t)blk * RBK * RBK; if (k0 < RBK) v0 = w[(size_t)k0 * RBK + jo]; if (k0 + 1 < RBK) v1 = w[(size_t)(k0 + 1) * RBK + jo]; }
          wgi[i] = cvt_pk_bf16(-1.4426950408889634f * v0, -1.4426950408889634f * v1); } }
    for (size_t i = gt; i < (size_t)2 * 128 * DM / 2; i += GT) {
        const int l = (int)(i / (128 * 512)), rr = (int)((i / 512) % 128), cw = (int)(i % 512);
        const int row = rr < 64 ? 1344 + rr : 2752 + (rr - 64);
        ((unsigned*)(wint + (size_t)l * UW * DM + (size_t)row * DM))[cw] = 0u;
    }
    for (size_t i = gt; i < (size_t)2 * DM * 32; i += GT) {
        const int l = (int)(i / (DM * 32)), row = (int)((i / 32) % DM), cw = (int)(i % 32);
        ((unsigned*)(wot + (size_t)l * DM * VK + (size_t)row * VK + DR))[cw] = 0u;
    }
}

__device__ __forceinline__ void normmod_phase(ArgsP a, const float* xlat, const float* xctx, const float* g, const float* modl  , int shift_part, int nrows, bf16_t* hout) {
    const int tid = otid(); const int lane = tid & 63, gw = obid() * 8 + (tid >> 6), NGW = ogrid() * 8;
    const int rpw = (nrows + NGW - 1) / NGW; const int r0 = gw * rpw; int r1 = r0 + rpw; if (r1 > nrows) r1 = nrows;
    f32x4 ca[4], cb[4]; int curb = -1;
    f32x4 gv[4];
#pragma unroll
    for (int j = 0; j < 4; ++j) gv[j] = *(const f32x4*)(g + 4 * lane + 256 * j);
    f32x4 v[4], vn[4];
    if (r0 < r1) { const float* xr = r0 < NLAT ? xlat + (size_t)r0 * DM : xctx + (size_t)(r0 - NLAT) * DM;
#pragma unroll
        for (int j = 0; j < 4; ++j) vn[j] = *(const f32x4*)(xr + 4 * lane + 256 * j); }
    for (int r = r0; r < r1; ++r) {
#pragma unroll
        for (int j = 0; j < 4; ++j) v[j] = vn[j];
        if (r + 1 < r1) { const int rn = r + 1; const float* xr = rn < NLAT ? xlat + (size_t)rn * DM : xctx + (size_t)(rn - NLAT) * DM;
#pragma unroll
            for (int j = 0; j < 4; ++j) vn[j] = *(const f32x4*)(xr + 4 * lane + 256 * j); }
        const int bidx = r < NLAT ? (r >> 11) : 32;
        if (bidx != curb) { curb = bidx; const float* mp = modl + (size_t)bidx * MODW + shift_part * DM;
#pragma unroll
            for (int j = 0; j < 4; ++j) { const f32x4 sh = *(const f32x4*)(mp + 4 * lane + 256 * j), sc = *(const f32x4*)(mp + DM + 4 * lane + 256 * j); ca[j] = gv[j] * (sc + 1.f); cb[j] = sh; } }
        float s = 0.f;
#pragma unroll
        for (int j = 0; j < 4; ++j) s += (v[j].x * v[j].x + v[j].y * v[j].y) + (v[j].z * v[j].z + v[j].w * v[j].w);
        const float rstd = rsqrtf(wave_sum(s) * (1.f / DM) + 1e-6f);
        u32x2* o = (u32x2*)(hout + (size_t)r * DM) + lane;
#pragma unroll
        for (int j = 0; j < 4; ++j) { const f32x4 y = (v[j] * rstd) * ca[j] + cb[j]; u32x2 w; w.x = cvt_pk_bf16(y.x, y.y); w.y = cvt_pk_bf16(y.z, y.w); o[64 * j] = w; }
    }
}

__device__ __forceinline__ void normmod_bf16_phase(ArgsP a, const bf16_t* xb, const float* g, const float* modl, int shift_part, int nrows, bf16_t* hout) {
    const int tid = otid(); const int lane = tid & 63, gw = obid() * 8 + (tid >> 6), NGW = ogrid() * 8;
    const int rpw = (nrows + NGW - 1) / NGW; const int r0 = gw * rpw; int r1 = r0 + rpw; if (r1 > nrows) r1 = nrows;
    f32x4 ca[4], cb[4], gv[4]; int curb = -1;
#pragma unroll
    for (int j = 0; j < 4; ++j) gv[j] = *(const f32x4*)(g + 8 * lane + 512 * (j >> 1) + 4 * (j & 1));
    u32x4 wn[2] = {};
    if (r0 < r1) {
#pragma unroll
        for (int j = 0; j < 2; ++j) wn[j] = *(const u32x4*)(xb + (size_t)r0 * DM + 8 * lane + 512 * j); }
    for (int r = r0; r < r1; ++r) {
        f32x4 v[4];
#pragma unroll
        for (int j = 0; j < 2; ++j) { v[2 * j] = (f32x4){bf_lo(wn[j].x), bf_hi(wn[j].x), bf_lo(wn[j].y), bf_hi(wn[j].y)}; v[2 * j + 1] = (f32x4){bf_lo(wn[j].z), bf_hi(wn[j].z), bf_lo(wn[j].w), bf_hi(wn[j].w)}; }
        if (r + 1 < r1) {
#pragma unroll
            for (int j = 0; j < 2; ++j) wn[j] = *(const u32x4*)(xb + (size_t)(r + 1) * DM + 8 * lane + 512 * j); }
        const int bidx = r < NLAT ? (r >> 11) : 32;
        if (bidx != curb) { curb = bidx; const float* mp = modl + (size_t)bidx * MODW + shift_part * DM;
#pragma unroll
            for (int j = 0; j < 4; ++j) { const int co = 8 * lane + 512 * (j >> 1) + 4 * (j & 1); const f32x4 sh = *(const f32x4*)(mp + co), sc = *(const f32x4*)(mp + DM + co); ca[j] = gv[j] * (sc + 1.f); cb[j] = sh; } }
        float s = 0.f;
#pragma unroll
        for (int j = 0; j < 4; ++j) s += (v[j].x * v[j].x + v[j].y * v[j].y) + (v[j].z * v[j].z + v[j].w * v[j].w);
        const float rstd = rsqrtf(wave_sum(s) * (1.f / DM) + 1e-6f);
#pragma unroll
        for (int j = 0; j < 2; ++j) { const f32x4 y0 = (v[2 * j] * rstd) * ca[2 * j] + cb[2 * j], y1 = (v[2 * j + 1] * rstd) * ca[2 * j + 1] + cb[2 * j + 1];
            u32x4 w; w.x = cvt_pk_bf16(y0.x, y0.y); w.y = cvt_pk_bf16(y0.z, y0.w); w.z = cvt_pk_bf16(y1.x, y1.y); w.w = cvt_pk_bf16(y1.z, y1.w);
            *(u32x4*)(hout + (size_t)r * DM + 8 * lane + 512 * j) = w; }
    }
}

__device__ __forceinline__ void final_phase(ArgsP a) {
    const int tid = otid(); const int lane = tid & 63, gw = obid() * 8 + (tid >> 6), NGW = ogrid() * 8;
    const bf16_t* xb = (const bf16_t*)(a->ws + WS_XB);
    f32x4 gv[4];
#pragma unroll
    for (int j = 0; j < 4; ++j) gv[j] = *(const f32x4*)(a->final_g + 8 * lane + 512 * (j >> 1) + 4 * (j & 1));
    u32x4 wn[2] = {};
    if (gw < NLAT) {
#pragma unroll
        for (int j = 0; j < 2; ++j) wn[j] = *(const u32x4*)(xb + (size_t)gw * DM + 8 * lane + 512 * j); }
    for (int r = gw; r < NLAT; r += NGW) {
        f32x4 v[4]; float s = 0.f;
#pragma unroll
        for (int j = 0; j < 2; ++j) { const u32x4 w = wn[j];
            v[2 * j] = (f32x4){bf_lo(w.x), bf_hi(w.x), bf_lo(w.y), bf_hi(w.y)}; v[2 * j + 1] = (f32x4){bf_lo(w.z), bf_hi(w.z), bf_lo(w.w), bf_hi(w.w)}; }
        if (r + NGW < NLAT) {
#pragma unroll
            for (int j = 0; j < 2; ++j) wn[j] = *(const u32x4*)(xb + (size_t)(r + NGW) * DM + 8 * lane + 512 * j); }
#pragma unroll
        for (int j = 0; j < 4; ++j) s += (v[j].x * v[j].x + v[j].y * v[j].y) + (v[j].z * v[j].z + v[j].w * v[j].w);
        const float rstd = rsqrtf(wave_sum(s) * (1.f / DM) + 1e-6f);
        float* orow = a->out + (size_t)r * DM;
#pragma unroll
        for (int j = 0; j < 4; ++j) *(f32x4*)(orow + 8 * lane + 512 * (j >> 1) + 4 * (j & 1)) = (v[j] * rstd) * gv[j];
    }
}

__device__ __forceinline__ void dft_mid_row(ArgsP a) {
    const int tid = otid(); const int lane = tid & 63, gw = obid() * 8 + (tid >> 6), NGW = ogrid() * 8;
    const bf16_t* pqt = (const bf16_t*)(a->ws + WS_BIG); bf16_t* f = (bf16_t*)(a->ws + WS_HBUF);
    for (int row0 = gw * 4; row0 < NB * DM; row0 += NGW * 4) {
        u32x4 w[4][4];
#pragma unroll
        for (int rr = 0; rr < 4; ++rr) { const u32x4* src = (const u32x4*)(pqt + (size_t)(row0 + rr) * 4096) + lane;
#pragma unroll
            for (int j = 0; j < 4; ++j) w[rr][j] = src[64 * j]; }
#pragma unroll
        for (int rr = 0; rr < 4; ++rr) { float s = 0.f;
#pragma unroll
            for (int j = 0; j < 4; ++j) { const u32x4 q = w[rr][j]; s += (bf_lo(q.x) - bf_hi(q.x)) + (bf_lo(q.y) - bf_hi(q.y)) + (bf_lo(q.z) - bf_hi(q.z)) + (bf_lo(q.w) - bf_hi(q.w)); }
            s = wave_sum(s) * 0.02209708691207961f;
            if (lane == 0) { const int row = row0 + rr, b = row >> 10, c = row & 1023; f[((size_t)b * SEQL + SEQL / 2) * DM + c] = (bf16_t)(cvt_pk_bf16(s, 0.f) & 0xffffu); } }
    }
}

constexpr int SC_XRB = 0;
constexpr int SC_WG = SC_XRB + 66 * 208;
constexpr int SAS = 112, SBS = 100;
constexpr int SC_SA = SC_WG + 192 * 208;
constexpr int SC_SB = SC_SA + 2 * 16 * SAS * 4;
constexpr int SC_SX = SC_SB + 64 * SBS * 4;
constexpr int SC_END = SC_SX + 66 * SBS * 4;
static_assert(SC_END <= LDS_BYTES, "scan LDS");

__device__ __forceinline__ void scan_phase(LAS unsigned char* lds, ArgsP a, int j, bool store_v) {
    const int tid = otid(), wave = tid >> 6, lane = tid & 63, fr = lane & 15, fq = lane >> 4; const int bid = obid(), gsz = ogrid();
    bf16_t* u = (bf16_t*)(a->ws + WS_BIG); bf16_t* hf = (bf16_t*)(a->ws + WS_HBUF);
    LAS unsigned char* xrb = lds + SC_XRB; LAS unsigned char* wg = lds + SC_WG;
    LAS float* sa = (LAS float*)(lds + SC_SA); LAS float* sb = (LAS float*)(lds + SC_SB); LAS float* sx = (LAS float*)(lds + SC_SX);
    const int p = tid % 42, tg = tid / 42; const bool cthr = tid < 462;
    const int mt = wave & 3, half = wave >> 2;
    constexpr float L2E = 1.4426950408889634f;
    for (int item = bid; item < NB * 16; item += gsz) {
        const int b = item >> 4, n = item & 15;
        float cwr[5][2];
#pragma unroll
        for (int k = 0; k < 5; ++k)
#pragma unroll
            for (int e = 0; e < 2; ++e) cwr[k][e] = k < 4 ? a->conv_w[((size_t)j * 4 + k) * DR + n * RBK + 2 * p + e] : a->conv_b[(size_t)j * DR + n * RBK + 2 * p + e];
        __syncthreads();
        for (int i = tid; i < 64 * 10; i += 512) { const int t = i / 10, q = i % 10; *(LAS unsigned*)(xrb + t * 208 + 168 + q * 4) = 0u; }
        for (int dir = 0; dir < 2; ++dir) {
            __syncthreads();
            { const u32x4* img = (const u32x4*)(a->ws + WS_WG + (((size_t)j * 2 + dir) * 16 + n) * WG_IMG);
              for (int i = tid; i < (int)(WG_IMG / 16); i += 512) *(LAS u32x4*)(wg + i * 16) = img[i]; }
            float ba[3], bi[3], cn1[3];
#pragma unroll
            for (int q = 0; q < 3; ++q) { const int ch = 16 * (3 * half + q) + fr; const bool ok = ch < RBK; const size_t o = ((size_t)j * 2 + dir) * DR + n * RBK + (ok ? ch : 0);
                ba[q] = -L2E * a->b_a[o]; bi[q] = -L2E * a->b_i[o]; const float lm = a->lam[o]; const float cneg = -8.f * log1pf(__expf(-lm)); cn1[q] = cneg * L2E; }
            float hcar = 0.f;
            __syncthreads();
            bf16x8 wfa[3][3], wfi0[3];
#pragma unroll
            for (int q = 0; q < 3; ++q)
#pragma unroll
                for (int ks = 0; ks < 3; ++ks) { const int nt = 3 * half + q;
                    wfa[q][ks] = *(const LAS bf16x8*)(wg + (16 * nt + fr) * 208 + ks * 64 + fq * 16);
                    if (q == 0) wfi0[ks] = *(const LAS bf16x8*)(wg + (96 + 16 * nt + fr) * 208 + ks * 64 + fq * 16); }
            unsigned px[9], phf[6], pgt[6];
            auto chunk_info = [&](int ci, int& tl0, int& Tseq, size_t& rowbase) {
                const int cc = dir == 0 ? ci : (ci < 4 ? 3 - ci : 39 - ci);
                if (cc < 4) { tl0 = cc * 64; Tseq = CTXL; rowbase = (size_t)NLAT + (size_t)b * CTXL; } else { tl0 = (cc - 4) * 64; Tseq = SEQL; rowbase = (size_t)b * SEQL; }
            };
            auto issue_x = [&](int ci) {
                int tl0, Tseq; size_t rowbase; chunk_info(ci, tl0, Tseq, rowbase);
                if (tl0 >= 64 && tl0 + 128 <= Tseq) {
                    if (cthr) { const bf16_t* bp = u + (rowbase + tl0 - 2 + tg * 6) * UW + XOFF + n * RBK + 2 * p;
#pragma unroll
                        for (int r = 0; r < 9; ++r) px[r] = *(const unsigned*)(bp + (size_t)r * UW); }
                } else {
#pragma unroll
                    for (int r = 0; r < 9; ++r) { const int t = tl0 - 2 + tg * 6 + r; px[r] = 0u;
                        if (cthr && t >= 0 && t < Tseq) px[r] = *(const unsigned*)(u + (rowbase + t) * UW + XOFF + n * RBK + 2 * p); } }
            };
            auto issue_hg = [&](int ci) {
                int tl0, Tseq; size_t rowbase; chunk_info(ci, tl0, Tseq, rowbase);
                if (cthr) {
#pragma unroll
                    for (int i = 0; i < 6; ++i) { const int tt = min(tg * 6 + i, 63); const size_t row = rowbase + tl0 + tt;
                        phf[i] = *(const unsigned*)(hf + row * DR + n * RBK + 2 * p); pgt[i] = *(const unsigned*)(u + row * UW + n * RBK + 2 * p); } }
            };
            auto conv_store = [&]() {
                if (cthr) {
#pragma unroll
                    for (int i = 0; i < 6; ++i) { const int tt = tg * 6 + i; float o0 = cwr[4][0], o1 = cwr[4][1];
#pragma unroll
                        for (int k = 0; k < 4; ++k) { o0 += cwr[k][0] * bf_lo(px[i + k]); o1 += cwr[k][1] * bf_hi(px[i + k]); }
                        *(LAS unsigned*)(xrb + tt * 208 + p * 4) = cvt_pk_bf16(o0, o1);
                        *(LAS f32x2*)(sx + tt * SBS + 2 * p) = (f32x2){o0, o1}; } }
            };
            issue_x(0);
            conv_store();
            issue_x(1);
            __syncthreads();
            for (int ci = 0; ci < 36; ++ci) {
                int tl0, Tseq; size_t rowbase; chunk_info(ci, tl0, Tseq, rowbase);
                if (dir == 1 && store_v) issue_hg(ci);
                float areg[3][4], breg[3][4];
                { bf16x8 af[3];
#pragma unroll
                  for (int ks = 0; ks < 3; ++ks) af[ks] = *(const LAS bf16x8*)(xrb + (16 * mt + fr) * 208 + ks * 64 + fq * 16);
#pragma unroll
                  for (int q = 0; q < 3; ++q) { const int nt = 3 * half + q;
                      f32x4 za = (f32x4){0.f, 0.f, 0.f, 0.f}, zi = (f32x4){0.f, 0.f, 0.f, 0.f};
#pragma unroll
                      for (int ks = 0; ks < 3; ++ks) { const bf16x8 bfi = (q == 0) ? wfi0[ks] : *(const LAS bf16x8*)(wg + (96 + 16 * nt + fr) * 208 + ks * 64 + fq * 16);
                          za = __builtin_amdgcn_mfma_f32_16x16x32_bf16(af[ks], wfa[q][ks], za, 0, 0, 0); zi = __builtin_amdgcn_mfma_f32_16x16x32_bf16(af[ks], bfi, zi, 0, 0, 0); }
                      const int ch = 16 * nt + fr;
#pragma unroll
                      for (int jj = 0; jj < 4; ++jj) { areg[q][jj] = 0.f; breg[q][jj] = 0.f; }
                      {
#pragma unroll
                          for (int jp = 0; jp < 2; ++jp) { const int t = 16 * mt + 4 * fq + 2 * jp;
                              f32x2 ea, ei; ea.x = __builtin_amdgcn_exp2f(za[2 * jp] + ba[q]); ea.y = __builtin_amdgcn_exp2f(za[2 * jp + 1] + ba[q]);
                              ei.x = __builtin_amdgcn_exp2f(zi[2 * jp] + bi[q]); ei.y = __builtin_amdgcn_exp2f(zi[2 * jp + 1] + bi[q]);
                              ea = ea + 1.f; ei = ei + 1.f;
                              f32x2 r, ig; r.x = __builtin_amdgcn_rcpf(ea.x); r.y = __builtin_amdgcn_rcpf(ea.y); ig.x = __builtin_amdgcn_rcpf(ei.x); ig.y = __builtin_amdgcn_rcpf(ei.y);
                              const f32x2 l2 = r * cn1[q];
                              f32x2 av; av.x = __builtin_amdgcn_exp2f(l2.x); av.y = __builtin_amdgcn_exp2f(l2.y);
                              const f32x2 om = 1.f - av * av;
                              f32x2 sq; sq.x = __builtin_amdgcn_sqrtf(fmaxf(om.x, 0.f)); sq.y = __builtin_amdgcn_sqrtf(fmaxf(om.y, 0.f));
                              f32x2 xv; xv.x = sx[t * SBS + ch]; xv.y = sx[(t + 1) * SBS + ch];
                              const f32x2 bb = sq * ig * xv;
                              areg[q][2 * jp] = av.x; areg[q][2 * jp + 1] = av.y; breg[q][2 * jp] = bb.x; breg[q][2 * jp + 1] = bb.y; }
                          float A, B;
                          if (dir == 0) { A = areg[q][0]; B = breg[q][0];
#pragma unroll
                              for (int jj = 1; jj < 4; ++jj) { B = B * areg[q][jj] + breg[q][jj]; A *= areg[q][jj]; } }
                          else { A = areg[q][3]; B = breg[q][3];
#pragma unroll
                              for (int jj = 2; jj >= 0; --jj) { B = B * areg[q][jj] + breg[q][jj]; A *= areg[q][jj]; } }
                          const int seg = 4 * mt + fq;
                          sa[seg * SAS + ch] = A; sa[16 * SAS + seg * SAS + ch] = B; }
                      __builtin_amdgcn_sched_barrier(0); } }
                __syncthreads();
                if (tid < RBK) {
                    float h = hcar; float Av[8], Bv[8];
#pragma unroll
                    for (int hh = 0; hh < 2; ++hh) { const int q0 = (dir == 0 ? hh : 1 - hh) * 8;
#pragma unroll
                        for (int q = 0; q < 8; ++q) { Av[q] = sa[(q0 + q) * SAS + tid]; Bv[q] = sa[16 * SAS + (q0 + q) * SAS + tid]; }
                        if (dir == 0) {
#pragma unroll
                            for (int q = 0; q < 8; ++q) { const float hin = h; h = Av[q] * h + Bv[q]; Bv[q] = hin; }
                        } else {
#pragma unroll
                            for (int q = 7; q >= 0; --q) { const float hin = h; h = Av[q] * h + Bv[q]; Bv[q] = hin; }
                        }
#pragma unroll
                        for (int q = 0; q < 8; ++q) sa[16 * SAS + (q0 + q) * SAS + tid] = Bv[q]; }
                    hcar = h;
                }
                if (ci + 1 < 36) { conv_store(); if (ci + 2 < 36) issue_x(ci + 2); }
                __syncthreads();
#pragma unroll
                for (int q = 0; q < 3; ++q) { const int ch = 16 * (3 * half + q) + fr;
                    { const int seg = 4 * mt + fq, t0 = 16 * mt + 4 * fq; float h = sa[16 * SAS + seg * SAS + ch];
                        if (dir == 0) {
#pragma unroll
                            for (int jj = 0; jj < 4; ++jj) { h = areg[q][jj] * h + breg[q][jj]; sb[(t0 + jj) * SBS + ch] = h; }
                        } else {
#pragma unroll
                            for (int jj = 3; jj >= 0; --jj) { h = areg[q][jj] * h + breg[q][jj]; sb[(t0 + jj) * SBS + ch] = h; }
                        } } }
                __syncthreads();
                if (cthr) {
                    if (dir == 0) {
#pragma unroll
                        for (int i = 0; i < 6; ++i) { const int tt = min(tg * 6 + i, 63); const f32x2 hv = *(const LAS f32x2*)(sb + tt * SBS + 2 * p);
                            *(unsigned*)(hf + (rowbase + tl0 + tt) * DR + n * RBK + 2 * p) = cvt_pk_bf16(hv.x, hv.y); }
                    } else if (store_v) {
#pragma unroll
                        for (int i = 0; i < 6; ++i) { const int tt = min(tg * 6 + i, 63); const f32x2 hv = *(const LAS f32x2*)(sb + tt * SBS + 2 * p);
                            const float v0 = (bf_lo(phf[i]) + hv.x) * bf_lo(pgt[i]), v1 = (bf_hi(phf[i]) + hv.y) * bf_hi(pgt[i]);
                            *(unsigned*)(u + (rowbase + tl0 + tt) * UW + n * RBK + 2 * p) = cvt_pk_bf16(v0, v1); }
                    }
                }
            }
        }
    }
}

extern "C" __global__ void __launch_bounds__(512) fwd_megakernel(Args a_unused) {
    extern __shared__ __attribute__((aligned(16))) unsigned char shm[];
    LAS unsigned char* lds = (LAS unsigned char*)shm;
    cg::grid_group grid = cg::this_grid();
    (void)a_unused;
    { ArgsP a0 = kargs(); unsigned* bar0 = (unsigned*)(a0->ws + WS_BAR);
      if (blockIdx.x == 0) for (int i = threadIdx.x; i < XCD_BAR_WORDS; i += 512) bar0[i] = 0u;
      if (threadIdx.x < 4) ((volatile LAS unsigned*)(lds + STAGE_BYTES))[threadIdx.x] = 0u; }
    prep_phase(lds, kargs());
    grid.sync();
    { ArgsP a0 = kargs(); unsigned* bar0 = (unsigned*)(a0->ws + WS_BAR); if (threadIdx.x == 0) (void)xb_add(&bar0[XB_XCNT(xb_xcc_id())], 1u); }
#define GRID_SYNC() xcd_barrier((unsigned*)(kargs()->ws + WS_BAR), (volatile LAS unsigned*)(lds + STAGE_BYTES))

    for (int op = -1; op < 36; ++op) {
        ArgsP a = kargs();
        bf16_t* xb = (bf16_t*)(a->ws + WS_XB); bf16_t* hbuf = (bf16_t*)(a->ws + WS_HBUF); bf16_t* big = (bf16_t*)(a->ws + WS_BIG);
        float* mod = (float*)(a->ws + WS_MOD);
        const int layer = op < 0 ? 0 : op / 9, step = op < 0 ? -1 : op % 9;
        const bool fourier = !(layer & 1), last = layer == 3; const int jl = layer >> 1;
        const int nMtok = last ? NLAT / BM : NTOK / BM;
        int type = 0; bool sync = true;
        GemmDesc g; g.a_s1 = g.a_s2 = g.b_s1 = g.b_s2 = 0; g.nZ = 1; g.zdiv = 1; g.mode = 0; g.Cb = nullptr; g.c_s1 = g.c_s2 = g.c_spm = 0; g.ldc = 0; g.act = 0; g.bias = nullptr;
        g.xs32_lat = g.xs32_ctx = nullptr; g.xb = nullptr; g.gate = nullptr; g.Cf = nullptr; g.mrows = 0; g.pm_off = 0; g.halfn = 0; g.A = nullptr; g.Bt = nullptr; g.lda = g.ldb = g.K = 0; g.nM = g.nN = 0;
        if (step == -1) {
            type = 1; g.A = (const bf16_t*)(a->ws + WS_AMOD); g.lda = DM; g.Bt = big; g.ldb = DM; g.K = DM; g.nM = 1; g.nN = MODW / BM; g.mode = 2; g.Cf = mod; g.ldc = MODW; g.bias = a->b_mod; g.mrows = 33;
        } else if (step == 0 || step == 6) {
            type = 2;
        } else if (step == 1) {
            type = 1;
            if (fourier) { g.A = (const bf16_t*)(a->ws + WS_FC); g.lda = 256; g.Bt = hbuf; g.ldb = DM; g.K = 256; g.nM = 2; g.nN = 8; g.nZ = 128; g.zdiv = 4; g.b_s1 = SEQL * DM; g.b_s2 = 256;
                g.Cb = big; g.c_s1 = 1024 * 4096; g.c_s2 = 256 * 4096; g.c_spm = 2048; g.ldc = 4096; sync = false; }
            else { g.A = hbuf; g.lda = DM; g.Bt = (const bf16_t*)(a->ws + WS_WINT) + (size_t)jl * UW * DM; g.ldb = DM; g.K = DM; g.nM = NTOK / BM; g.nN = UW / BM; g.Cb = big; g.c_spm = BM * UW; g.ldc = UW; g.act = 2; }
        } else if (step == 2) {
            if (fourier) { type = 1; g.A = (const bf16_t*)(a->ws + WS_FC); g.lda = 256; g.Bt = hbuf + (size_t)NLAT * DM; g.ldb = DM; g.K = 256; g.nM = 2; g.nN = 1; g.nZ = 128; g.zdiv = 4; g.b_s1 = CTXL * DM; g.b_s2 = 256;
                g.Cb = (bf16_t*)(a->ws + WS_BIG + BIG_PQTC); g.c_s1 = 1024 * 512; g.c_s2 = 256 * 512; g.c_spm = 256; g.ldc = 512; }
            else type = 3;
        } else if (step == 3) {
            if (fourier) { type = 1; g.A = (const bf16_t*)(a->ws + WS_FT); g.lda = 4096; g.Bt = big; g.ldb = 4096; g.K = 4096; g.nM = 4; g.nN = 4; g.nZ = 32; g.b_s1 = 1024 * 4096;
                g.Cb = hbuf; g.c_s1 = SEQL * DM; g.c_spm = BM * DM; g.ldc = DM; g.act = 3; sync = false; }
            else sync = false;
        } else if (step == 4) {
            if (fourier) { type = 1; g.A = (const bf16_t*)(a->ws + WS_FTC); g.lda = 512; g.Bt = (const bf16_t*)(a->ws + WS_BIG + BIG_PQTC); g.ldb = 512; g.K = 512; g.nM = 1; g.nN = 4; g.nZ = 32; g.b_s1 = 1024 * 512;
                g.Cb = hbuf + (size_t)NLAT * DM; g.c_s1 = CTXL * DM; g.c_spm = BM * DM; g.ldc = DM; }
            else sync = false;
        } else if (step == 5) {
            type = 1; g.mode = 1; g.nM = NLAT / BM; g.nN = 4; g.gate = mod + layer * 6 * DM + 2 * DM; g.xb = xb; if (layer == 0) { g.xs32_lat = a->x; g.xs32_ctx = a->ctx; }
            if (fourier) { g.A = hbuf; g.lda = DM; g.Bt = (const bf16_t*)(a->ws + WS_WFT) + (size_t)jl * DM * DM; g.ldb = DM; g.K = DM; }
            else { g.A = big; g.lda = UW; g.Bt = (const bf16_t*)(a->ws + WS_WOT) + (size_t)jl * DM * VK; g.ldb = VK; g.K = VK; }
        } else if (step == 7) {
            type = 1; g.A = hbuf; g.lda = DM; g.Bt = (const bf16_t*)(a->ws + WS_W1T) + (size_t)layer * DFF * DM; g.ldb = DM; g.K = DM; g.nM = nMtok; g.nN = DFF / BM; g.Cb = big; g.c_spm = BM * DFF; g.ldc = DFF; g.bias = a->b1 + layer * DFF; g.act = 1;
        } else {
            type = 1; g.mode = 1; g.A = big; g.lda = DFF; g.Bt = (const bf16_t*)(a->ws + WS_W2T) + (size_t)layer * DM * DFF; g.ldb = DFF; g.K = DFF; g.nM = NLAT / BM; g.nN = 4;
            g.gate = mod + layer * 6 * DM + 5 * DM; g.bias = a->b2 + layer * DM; g.xb = xb;
        }
#ifndef NO_GEMM
        if (type == 1) {
#if DUP_UP
            if (step == 7) { gemm_phase(lds, g); GRID_SYNC(); }
#endif
#if DUP_DFT
            if (fourier && step >= 1 && step <= 4) { gemm_phase(lds, g); if (sync) GRID_SYNC(); }
#endif
            gemm_phase(lds, g);
            if ((step == 5 || step == 8) && !last) {
                g.A += (size_t)(NLAT / BM) * BM * g.lda; g.nM = NCTX / BM; g.pm_off = NLAT / BM; g.halfn = 1; gemm_phase(lds, g); }
            if (fourier && step == 3) dft_mid_row(a); }
#endif
        else if (type == 2) {
#if DUP_NORM
            if (step == 0 && layer == 0) normmod_phase(a, a->x, a->ctx, a->norm_g, mod, 0, NTOK, hbuf);
            else if (step == 0) normmod_bf16_phase(a, xb, a->norm_g + (layer * 2 + 0) * DM, mod + layer * 6 * DM, 0, NTOK, hbuf);
            else normmod_bf16_phase(a, xb, a->norm_g + (layer * 2 + 1) * DM, mod + layer * 6 * DM, 3, last ? NLAT : NTOK, hbuf);
            GRID_SYNC();
#endif
            if (step == 0 && layer == 0) normmod_phase(a, a->x, a->ctx, a->norm_g, mod, 0, NTOK, hbuf);
            else if (step == 0) normmod_bf16_phase(a, xb, a->norm_g + (layer * 2 + 0) * DM, mod + layer * 6 * DM, 0, NTOK, hbuf);
            else normmod_bf16_phase(a, xb, a->norm_g + (layer * 2 + 1) * DM, mod + layer * 6 * DM, 3, last ? NLAT : NTOK, hbuf);
        }
#ifndef NO_SCAN
        else if (type == 3) {
#if DUP_SCAN
            scan_phase(lds, a, jl, false); GRID_SYNC();
#endif
            scan_phase(lds, a, jl, true); }
#endif
        if (sync) GRID_SYNC();
#if DUP_SYNC
        if (sync) GRID_SYNC();
#endif
    }
    final_phase(kargs());
}

extern "C" void kernel_launch(void* const* d_in, const int* in_sizes, int n_in, void* d_out, int out_size, void* d_ws, size_t ws_size, hipStream_t stream) {
    static int grid = 0;
    if (!grid) {
        if (n_in != 22 || out_size != NLAT * DM || ws_size < WS_END) { fprintf(stderr, "kernel_launch: unexpected shapes (n_in %d out %d ws %zu need %zu)\n", n_in, out_size, ws_size, (size_t)WS_END); grid = -1; return; }
        int dev = 0, cus = 0, per_cu = 0;
        (void)hipGetDevice(&dev);
        (void)hipDeviceGetAttribute(&cus, hipDeviceAttributeMultiprocessorCount, dev);
        (void)hipFuncSetAttribute((const void*)fwd_megakernel, hipFuncAttributeMaxDynamicSharedMemorySize, LDS_BYTES);
        (void)hipOccupancyMaxActiveBlocksPerMultiprocessor(&per_cu, (const void*)fwd_megakernel, 512, LDS_BYTES);
        if (per_cu < 1) per_cu = 1;
        grid = cus * per_cu;
    }
    if (grid < 0) return;
    Args a{};
    const float** ap = (const float**)&a;
    for (int i = 0; i < 22; ++i) ap[i] = (const float*)d_in[i];
    a.out = (float*)d_out; a.ws = (unsigned char*)d_ws;
    void* args[] = {&a};
    hipError_t e = hipLaunchCooperativeKernel((const void*)fwd_megakernel, dim3(grid), dim3(512), args, LDS_BYTES, stream);
    if (e != hipSuccess) fprintf(stderr, "cooperative launch failed: %s (grid %d)\n", hipGetErrorString(e), grid);
}
```
